# Optimizing an MI355X kernel written in HIP

```python
import jax
import jax.numpy as jnp
from jax import lax
import numpy as np

D_MODEL = 1024
BATCH = 2
SEQ = 8192
DEPTH = 1

CTX_LEN = 256
GRID_W = 64
D_MIX = D_MODEL
RW_WIDTH = D_MIX // 2
RW_HEAD = 64
RW_HEADS = RW_WIDTH // RW_HEAD
DECAY_LORA = 64
AAA_LORA = 64
MLA_WIDTH = D_MIX - RW_WIDTH
MLA_HEADS = 8
QK_NOPE = 64
QK_ROPE = 32
QK_DIM = QK_NOPE + QK_ROPE
V_HEAD = MLA_WIDTH // MLA_HEADS
Q_LORA = 384
KV_LORA = 256
AXIS_DIM = QK_ROPE // 2
ROPE_THETA = 10000.0
Q_BLOCK = 128
NORM_EPS = 1e-6
LNX_EPS = 64e-5
ATTN_SCALE = QK_DIM ** -0.5
N_SHIFT = 3 * RW_WIDTH + 2 * DECAY_LORA + 2 * AAA_LORA
MLA_LAT = Q_LORA + KV_LORA + QK_ROPE
D_IN = N_SHIFT + RW_WIDTH + MLA_LAT + MLA_WIDTH
SPLITS = (N_SHIFT, N_SHIFT + RW_WIDTH, N_SHIFT + RW_WIDTH + MLA_LAT)

kernel_name = 'hymba_rwkv7_mla_dit_block'


def rms_norm(x, g):
    xf = x.astype(jnp.float32)
    y = xf * lax.rsqrt(jnp.mean(xf * xf, axis=-1, keepdims=True) + NORM_EPS)
    return (y * g.astype(jnp.float32)).astype(x.dtype)


def token_shift(u, mu_prev, mu_next):
    prev = jnp.pad(u[:, :-1], ((0, 0), (1, 0), (0, 0)))
    nxt = jnp.pad(u[:, 1:], ((0, 0), (0, 1), (0, 0)))
    return u + mu_prev * (prev - u) + mu_next * (nxt - u)


def to_heads(t):
    return t.reshape(t.shape[:-1] + (RW_HEADS, RW_HEAD))


def rwkv_prep(u_shift, mu, w0, w2, a0, a2, k_k, k_a):
    us = token_shift(u_shift, mu[0], mu[1])
    r, k, v, w_in, a_in = jnp.split(
        us, [RW_WIDTH, 2 * RW_WIDTH, 3 * RW_WIDTH, 3 * RW_WIDTH + 2 * DECAY_LORA], axis=-1)
    B, L = us.shape[:2]
    w_in = w_in.reshape(B, L, 2, DECAY_LORA)
    a_in = a_in.reshape(B, L, 2, AAA_LORA)
    w_log = -jax.nn.softplus(-(w0[:, None, None, :] + jnp.einsum('blde,def->dblf', jnp.tanh(w_in), w2))) - 0.5
    decay = jnp.exp(-jnp.exp(w_log.astype(jnp.float32)))
    a = jax.nn.sigmoid(a0[:, None, None, :] + jnp.einsum('blde,def->dblf', a_in, a2))
    kkf = to_heads(k * k_k).astype(jnp.float32)
    kk = (kkf * lax.rsqrt(jnp.maximum(jnp.sum(kkf * kkf, -1, keepdims=True), 1e-24))).astype(k.dtype)
    a = to_heads(a)
    k_dir = to_heads(k)[None] * (1 + (a - 1) * to_heads(k_a))
    b_dir = kk[None] * a
    return to_heads(r), kk, to_heads(v), to_heads(decay), k_dir, b_dir


def rwkv_scan(state0, r, decay, k, v, a_neg, b, reverse, emit):
    xs = tuple(jnp.moveaxis(t.astype(jnp.float32), 1, 0) for t in (r, decay, k, v, a_neg, b))

    def step(S, inp):
        r_t, w_t, k_t, v_t, a_t, b_t = inp
        sa = jnp.einsum('bhij,bhj->bhi', S, a_t)
        S = S * w_t[:, :, None, :] + sa[..., None] * b_t[:, :, None, :] + v_t[..., None] * k_t[:, :, None, :]
        y = jnp.einsum('bhij,bhj->bhi', S, r_t) if emit else None
        return S, y

    S, ys = lax.scan(step, state0, xs, reverse=reverse)
    return S, (jnp.moveaxis(ys, 0, 1) if emit else None)


def rwkv_branch(prep, states0, r_k, lnx_g, lnx_b, gate, emit):
    r, kk, v, decay, k_dir, b_dir = prep
    S_f, y_f = rwkv_scan(states0[0], r, decay[0], k_dir[0], v, -kk, b_dir[0], False, emit)
    S_b, y_b = rwkv_scan(states0[1], r, decay[1], k_dir[1], v, -kk, b_dir[1], True, emit)
    if not emit:
        return None, (S_f, S_b)
    y = y_f + y_b
    mean = jnp.mean(y, -1, keepdims=True)
    var = jnp.mean(jnp.square(y - mean), -1, keepdims=True)
    yn = (y - mean) * lax.rsqrt(var + LNX_EPS) * to_heads(lnx_g).astype(jnp.float32) \
        + to_heads(lnx_b).astype(jnp.float32)
    bonus = jnp.sum(r * (k_dir[0] + k_dir[1]) * r_k, -1, keepdims=True) * v
    out = (yn + bonus.astype(jnp.float32)).astype(gate.dtype)
    B, L = gate.shape[:2]
    return out.reshape(B, L, RW_WIDTH) * jax.nn.silu(gate), (S_f, S_b)


def rot_half(t, cos, sin):
    t1, t2 = t[..., :AXIS_DIM // 2], t[..., AXIS_DIM // 2:]
    return jnp.concatenate([t1 * cos - t2 * sin, t1 * sin + t2 * cos], axis=-1)


def rope_axial(t, cos_r, sin_r, cos_c, sin_c):
    return jnp.concatenate([rot_half(t[..., :AXIS_DIM], cos_r, sin_r),
                            rot_half(t[..., AXIS_DIM:], cos_c, sin_c)], axis=-1)


def mla_queries(u_mla, q_g, w_uq, rot):
    B, L = u_mla.shape[:2]
    c_q = rms_norm(u_mla[..., :Q_LORA], q_g)
    q = jnp.einsum('blr,rf->blf', c_q, w_uq).reshape(B, L, MLA_HEADS, QK_DIM)
    if rot is not None:
        q = jnp.concatenate([q[..., :QK_NOPE], rope_axial(q[..., QK_NOPE:], *rot)], axis=-1)
    return q


def mla_keys_values(u_mla, kv_g, w_ukv, rot):
    B, L = u_mla.shape[:2]
    c_kv = rms_norm(u_mla[..., Q_LORA:Q_LORA + KV_LORA], kv_g)
    k_r = u_mla[..., Q_LORA + KV_LORA:][:, :, None, :]
    if rot is not None:
        k_r = rope_axial(k_r, *rot)
    kv = jnp.einsum('blr,rf->blf', c_kv, w_ukv).reshape(B, L, MLA_HEADS, QK_NOPE + V_HEAD)
    k_nope, v = kv[..., :QK_NOPE], kv[..., QK_NOPE:]
    k = jnp.concatenate([k_nope, jnp.broadcast_to(k_r, (B, L, MLA_HEADS, QK_ROPE))], axis=-1)
    return k, v


def softmax_attend(q, k, v):
    s = jnp.einsum('bqhd,bkhd->bhqk', q, k).astype(jnp.float32) * ATTN_SCALE
    p = jax.nn.softmax(s, axis=-1).astype(v.dtype)
    return jnp.einsum('bhqk,bkhd->bqhd', p, v)


def block_attention(q, k_all, v_all):
    B, L, H, dk = q.shape
    nb = L // Q_BLOCK
    qb = q.reshape(B, nb, Q_BLOCK, H, dk).swapaxes(0, 1)
    o = lax.map(lambda blk: softmax_attend(blk, k_all, v_all), qb)
    return o.swapaxes(0, 1).reshape(B, L, H * V_HEAD)


def hybrid_layer(x, ctx, mod, mod_c, rot, params, need_ctx_out):
    (norm_g, w_in, shift_mu, rw_w0, rw_w2, rw_a0, rw_a2, rw_kk, rw_ka, rw_rk,
     rw_lnx_g, rw_lnx_b, q_g, kv_g, w_uq, w_ukv, w_out) = params
    B, L = x.shape[:2]
    shift, scale, gate = jnp.split(mod, 3, axis=-1)
    shift_c, scale_c, gate_c = jnp.split(mod_c, 3, axis=-1)
    h = rms_norm(x, norm_g) * (1 + scale) + shift
    hc = rms_norm(ctx, norm_g) * (1 + scale_c) + shift_c
    u_sh, g_rw, u_mla, g_mla = jnp.split(h @ w_in, SPLITS, axis=-1)
    uc_sh, gc_rw, uc_mla, gc_mla = jnp.split(hc @ w_in, SPLITS, axis=-1)

    rw_p = (shift_mu, rw_w0, rw_w2, rw_a0, rw_a2, rw_kk, rw_ka)
    S0 = jnp.zeros((B, RW_HEADS, RW_HEAD, RW_HEAD), jnp.float32)
    rw_c, ctx_states = rwkv_branch(rwkv_prep(uc_sh, *rw_p), (S0, S0), rw_rk, rw_lnx_g, rw_lnx_b,
                                   gc_rw, need_ctx_out)
    rw_l, _ = rwkv_branch(rwkv_prep(u_sh, *rw_p), ctx_states, rw_rk, rw_lnx_g, rw_lnx_b, g_rw, True)

    kc, vc = mla_keys_values(uc_mla, kv_g, w_ukv, None)
    k, v = mla_keys_values(u_mla, kv_g, w_ukv, rot)
    q = mla_queries(u_mla, q_g, w_uq, rot)
    o = block_attention(q, jnp.concatenate([k, kc], axis=1), jnp.concatenate([v, vc], axis=1))
    mla_l = o * jax.nn.silu(g_mla)

    x = x + gate * (jnp.concatenate([rw_l, mla_l], axis=-1) @ w_out)
    if need_ctx_out:
        qc = mla_queries(uc_mla, q_g, w_uq, None)
        mla_c = softmax_attend(qc, kc, vc).reshape(B, ctx.shape[1], MLA_WIDTH) * jax.nn.silu(gc_mla)
        ctx = ctx + gate_c * (jnp.concatenate([rw_c, mla_c], axis=-1) @ w_out)
    return x, ctx


def setup_inputs(seed: int = 0) -> dict:
    key = jax.random.key(seed)
    ks = jax.random.split(key, 24)
    f32 = jnp.float32

    def nrm(k, shape, s):
        return jax.random.normal(k, shape, f32) * s

    return {
        'x': nrm(ks[0], (BATCH, SEQ, D_MODEL), 1.0),
        'c': nrm(ks[1], (BATCH, D_MODEL), 1.0),
        'ctx': nrm(ks[2], (BATCH, CTX_LEN, D_MODEL), 1.0),
        'c_ctx': nrm(ks[3], (D_MODEL,), 1.0),
        'ada_w': nrm(ks[4], (DEPTH, D_MODEL, 3 * D_MODEL), 0.5 * D_MODEL ** -0.5),
        'ada_b': nrm(ks[5], (DEPTH, 3 * D_MODEL), 0.02),
        'norm_g': 1.0 + nrm(ks[6], (DEPTH, D_MODEL), 0.05),
        'w_in': nrm(ks[7], (DEPTH, D_MODEL, D_IN), D_MODEL ** -0.5),
        'shift_mu': jax.random.uniform(ks[8], (DEPTH, 2, N_SHIFT), f32, 0.0, 0.5),
        'rw_w0': jax.random.uniform(ks[9], (DEPTH, 2, RW_WIDTH), f32, -6.5, -1.5),
        'rw_w2': nrm(ks[10], (DEPTH, 2, DECAY_LORA, RW_WIDTH), 0.1 * DECAY_LORA ** -0.5),
        'rw_a0': nrm(ks[11], (DEPTH, 2, RW_WIDTH), 0.1),
        'rw_a2': nrm(ks[12], (DEPTH, 2, AAA_LORA, RW_WIDTH), AAA_LORA ** -0.5),
        'rw_kk': 0.85 + nrm(ks[13], (DEPTH, RW_WIDTH), 0.02),
        'rw_ka': 1.0 + nrm(ks[14], (DEPTH, RW_WIDTH), 0.02),
        'rw_rk': nrm(ks[15], (DEPTH, RW_HEADS, RW_HEAD), 0.1),
        'rw_lnx_g': 1.0 + nrm(ks[16], (DEPTH, RW_WIDTH), 0.05),
        'rw_lnx_b': nrm(ks[17], (DEPTH, RW_WIDTH), 0.02),
        'mla_q_norm_g': 1.0 + nrm(ks[18], (DEPTH, Q_LORA), 0.05),
        'mla_kv_norm_g': 1.0 + nrm(ks[19], (DEPTH, KV_LORA), 0.05),
        'mla_w_uq': nrm(ks[20], (DEPTH, Q_LORA, MLA_HEADS * QK_DIM), Q_LORA ** -0.5),
        'mla_w_ukv': nrm(ks[21], (DEPTH, KV_LORA, MLA_HEADS * (QK_NOPE + V_HEAD)), KV_LORA ** -0.5),
        'w_out': nrm(ks[22], (DEPTH, D_MIX, D_MODEL), D_MIX ** -0.5),
        'final_g': 1.0 + nrm(ks[23], (D_MODEL,), 0.05),
    }


def reference(x, c, ctx, c_ctx, ada_w, ada_b, norm_g, w_in, shift_mu, rw_w0, rw_w2, rw_a0, rw_a2,
              rw_kk, rw_ka, rw_rk, rw_lnx_g, rw_lnx_b, mla_q_norm_g, mla_kv_norm_g, mla_w_uq,
              mla_w_ukv, w_out, final_g):
    L = x.shape[1]
    rows = L // GRID_W
    row = jnp.repeat(jnp.arange(rows, dtype=jnp.float32), GRID_W)
    col = jnp.tile(jnp.arange(GRID_W, dtype=jnp.float32), rows)
    inv_freq = ROPE_THETA ** (-jnp.arange(0, AXIS_DIM, 2, dtype=jnp.float32) / AXIS_DIM)
    ang_r = (row[:, None] * inv_freq)[:, None, :]
    ang_c = (col[:, None] * inv_freq)[:, None, :]
    rot = (jnp.cos(ang_r).astype(x.dtype), jnp.sin(ang_r).astype(x.dtype),
           jnp.cos(ang_c).astype(x.dtype), jnp.sin(ang_c).astype(x.dtype))

    for i in range(DEPTH):
        mod = (jax.nn.silu(c) @ ada_w[i] + ada_b[i])[:, None, :]
        mod_c = jax.nn.silu(c_ctx) @ ada_w[i] + ada_b[i]
        params = (norm_g[i], w_in[i], shift_mu[i], rw_w0[i], rw_w2[i], rw_a0[i], rw_a2[i], rw_kk[i],
                  rw_ka[i], rw_rk[i], rw_lnx_g[i], rw_lnx_b[i], mla_q_norm_g[i], mla_kv_norm_g[i],
                  mla_w_uq[i], mla_w_ukv[i], w_out[i])
        x, ctx = hybrid_layer(x, ctx, mod, mod_c, rot, params, i < DEPTH - 1)
    return rms_norm(x, final_g)
```

```cpp
#include <hip/hip_runtime.h>
#include <hip/hip_cooperative_groups.h>
#include <stdint.h>
#include <stdio.h>
namespace cg = cooperative_groups;

#ifndef PROBE
#define PROBE 0
#endif
#ifndef ONE_LAUNCH
#define ONE_LAUNCH 1
#endif

#define DI __device__ __forceinline__
typedef unsigned short bf16_t;
using bf16x8 = __attribute__((ext_vector_type(8))) short;
using f32x16 = __attribute__((ext_vector_type(16))) float;
using f2 = __attribute__((ext_vector_type(2))) float;

constexpr int T_LAT = 16384, T_ALL = 16896, SEQ = 8192, CTXL = 256, LK = 8448;
constexpr int NTHR = 512;
constexpr int NPHASE = 9;
constexpr int NSCAN = 128;

constexpr size_t OFF_MOD   = 0;
constexpr size_t OFF_CTR   = 36864;
constexpr size_t OFF_BAR   = 40960;
constexpr size_t OFF_WIN_T = 65536;
constexpr size_t OFF_WOUT_T= OFF_WIN_T + 3584ull*1024*2;
constexpr size_t OFF_WUQ_T = OFF_WOUT_T + 1024ull*1024*2;
constexpr size_t OFF_WUKV_T= OFF_WUQ_T + 768ull*384*2;
constexpr size_t OFF_WL_T  = OFF_WUKV_T + 1024ull*256*2;
constexpr size_t SMALL_END = 11ull*1048576;
constexpr size_t OFF_X1    = SMALL_END;
constexpr size_t OFF_USH   = OFF_X1;
constexpr size_t OFF_UMLA  = OFF_X1 + (size_t)T_ALL*1792*2;
constexpr size_t SZ_ARR    = (size_t)T_ALL*512*2;
constexpr size_t OFF_E     = OFF_X1;
constexpr size_t OFF_A     = OFF_X1 + 2*SZ_ARR;
constexpr size_t OFF_X2    = OFF_X1 + (size_t)T_ALL*(1792+672)*2;
constexpr size_t OFF_H     = OFF_X2;
constexpr size_t OFF_CQ    = OFF_X2;
constexpr size_t OFF_CKV   = OFF_CQ + (size_t)T_ALL*384*2;
constexpr size_t OFF_LW    = OFF_CKV + (size_t)T_ALL*256*2;
constexpr size_t OFF_MIX   = OFF_X2;
constexpr size_t OFF_X3    = OFF_X2 + (size_t)T_ALL*1024*2;
constexpr size_t OFF_R     = OFF_X3;
constexpr size_t OFF_K     = OFF_X3 + SZ_ARR;
constexpr size_t OFF_V     = OFF_X3 + 2*SZ_ARR;
constexpr size_t OFF_KK    = OFF_X3 + 3*SZ_ARR;
constexpr size_t OFF_KR    = OFF_X3 + 4*SZ_ARR;
constexpr size_t OFF_KN    = OFF_KR + 2ull*LK*32*2;
constexpr size_t OFF_VT    = OFF_KN + 2ull*8*LK*64*2;
constexpr size_t OFF_YB    = OFF_VT + 2ull*8*LK*64*2;
constexpr size_t WS_END    = OFF_YB + (size_t)T_LAT*512*2;
static_assert(WS_END <= 256ull*1048576, "workspace overflow");
constexpr size_t OOFF_G = 0;
constexpr size_t OOFF_Q = (size_t)T_LAT*1024*2;

struct Params {
  const float *x,*c,*ctx,*c_ctx,*ada_w,*ada_b,*norm_g,*w_in,*shift_mu,*rw_w0,*rw_w2,*rw_a0,*rw_a2,*rw_kk,*rw_ka,*rw_rk,
              *lnx_g,*lnx_b,*q_g,*kv_g,*w_uq,*w_ukv,*w_out,*final_g;
  float* out; unsigned char* ws;
  int ph_lo, ph_hi;
};

DI float bf2f(unsigned short b) { return __uint_as_float(((unsigned)b) << 16); }
typedef __bf16 hbf2 __attribute__((ext_vector_type(2)));
DI unsigned pack2(float a, float b) { f2 v = {a, b}; return __builtin_bit_cast(unsigned, __builtin_convertvector(v, hbf2)); }
DI unsigned short f2bf(float x) { return (unsigned short)(pack2(x, x) & 0xffffu); }
DI float lo16(unsigned u) { return __uint_as_float(u << 16); }
DI float hi16(unsigned u) { return __uint_as_float(u & 0xffff0000u); }
#define UNPACK8(v, f) do { f[0]=lo16(v.x); f[1]=hi16(v.x); f[2]=lo16(v.y); f[3]=hi16(v.y); f[4]=lo16(v.z); f[5]=hi16(v.z); f[6]=lo16(v.w); f[7]=hi16(v.w); } while (0)
#define PACK8(f) make_uint4(pack2(f[0],f[1]), pack2(f[2],f[3]), pack2(f[4],f[5]), pack2(f[6],f[7]))
DI float wave_sum(float v) { for (int o = 32; o > 0; o >>= 1) v += __shfl_xor(v, o); return v; }
DI float sum8(float v) { v += __shfl_xor(v, 1); v += __shfl_xor(v, 2); v += __shfl_xor(v, 4); return v; }
DI float siluf(float x) { return x / (1.f + __expf(-x)); }
DI float xhalf_max(float m) { const auto r = __builtin_amdgcn_permlane32_swap(__float_as_uint(m), __float_as_uint(m), false, false); return fmaxf(__uint_as_float(r[0]), __uint_as_float(r[1])); }
DI int crow(int i, int hh) { return (i & 3) + 8 * (i >> 2) + 4 * hh; }

constexpr int BM = 256, BN = 256, BK = 64, LDT = 72;
struct GemmDesc { const bf16_t* A; int lda; const bf16_t* Bt; int ldb; int K; };

template <class Epi>
DI void gemm_tile(const GemmDesc g, int m0, int n0, unsigned char* lds, Epi& epi) {
  int tid = threadIdx.x; asm volatile("" : "+v"(tid));
  const int lane = tid & 63, w = tid >> 6;
  constexpr int ASZ = BM * LDT, BSZ = BN * LDT;
  bf16_t* As = (bf16_t*)lds;
  bf16_t* Bs = As + 2 * ASZ;
  const int wm = w >> 2, wn = w & 3;
  f32x16 acc[4][2];
#pragma unroll
  for (int i = 0; i < 4; ++i)
#pragma unroll
    for (int j = 0; j < 2; ++j)
#pragma unroll
      for (int e = 0; e < 16; ++e) acc[i][j][e] = 0.f;
  uint4 ra0, ra1, ra2, ra3, rb0, rb1, rb2, rb3;
  const int nk = g.K / BK;
  const bf16_t* gA = g.A + (size_t)(m0 + (tid >> 3)) * g.lda + (tid & 7) * 8;
  const bf16_t* gB = g.Bt + (size_t)(n0 + (tid >> 3)) * g.ldb + (tid & 7) * 8;
  const size_t sA = (size_t)64 * g.lda, sB = (size_t)64 * g.ldb;
  bf16_t* lA = As + (tid >> 3) * LDT + (tid & 7) * 8;
  bf16_t* lB = Bs + (tid >> 3) * LDT + (tid & 7) * 8;
  const bf16_t* fA = As + (wm * 128 + (lane & 31)) * LDT + (lane >> 5) * 8;
  const bf16_t* fB = Bs + (wn * 64 + (lane & 31)) * LDT + (lane >> 5) * 8;
#define GLOAD(kt) do { const int ko = (kt) * BK; \
    ra0 = *(const uint4*)(gA + ko); ra1 = *(const uint4*)(gA + sA + ko); ra2 = *(const uint4*)(gA + 2 * sA + ko); ra3 = *(const uint4*)(gA + 3 * sA + ko); \
    rb0 = *(const uint4*)(gB + ko); rb1 = *(const uint4*)(gB + sB + ko); rb2 = *(const uint4*)(gB + 2 * sB + ko); rb3 = *(const uint4*)(gB + 3 * sB + ko); } while (0)
#define LSTORE(st) do { \
    *(uint4*)(lA + (st) * ASZ) = ra0; *(uint4*)(lA + (st) * ASZ + 64 * LDT) = ra1; *(uint4*)(lA + (st) * ASZ + 128 * LDT) = ra2; *(uint4*)(lA + (st) * ASZ + 192 * LDT) = ra3; \
    *(uint4*)(lB + (st) * BSZ) = rb0; *(uint4*)(lB + (st) * BSZ + 64 * LDT) = rb1; *(uint4*)(lB + (st) * BSZ + 128 * LDT) = rb2; *(uint4*)(lB + (st) * BSZ + 192 * LDT) = rb3; } while (0)
#define COMPUTE(st) do { \
    _Pragma("unroll") for (int kk = 0; kk < 4; ++kk) { \
      bf16x8 a[4], b[2]; \
      _Pragma("unroll") for (int i = 0; i < 4; ++i) a[i] = *(const bf16x8*)(fA + (st) * ASZ + i * 32 * LDT + kk * 16); \
      _Pragma("unroll") for (int j = 0; j < 2; ++j) b[j] = *(const bf16x8*)(fB + (st) * BSZ + j * 32 * LDT + kk * 16); \
      _Pragma("unroll") for (int i = 0; i < 4; ++i) \
        _Pragma("unroll") for (int j = 0; j < 2; ++j) acc[i][j] = __builtin_amdgcn_mfma_f32_32x32x16_bf16(a[i], b[j], acc[i][j], 0, 0, 0); } } while (0)
  __syncthreads();
  GLOAD(0);
  LSTORE(0);
  __syncthreads();
  for (int kt = 0; kt < nk; kt += 2) {
    const bool h1 = kt + 1 < nk, h2 = kt + 2 < nk;
    if (h1) GLOAD(kt + 1);
    COMPUTE(0);
    if (h1) LSTORE(1);
    __syncthreads();
    if (h1) {
      if (h2) GLOAD(kt + 2);
      COMPUTE(1);
      if (h2) LSTORE(0);
      __syncthreads();
    }
  }
#undef GLOAD
#undef LSTORE
#undef COMPUTE
#pragma unroll
  for (int i = 0; i < 4; ++i)
#pragma unroll
    for (int j = 0; j < 2; ++j) epi(m0 + wm * 128 + i * 32 + 4 * (lane >> 5), n0 + wn * 64 + j * 32 + (lane & 31), acc[i][j]);
}

struct EpiP1 { bf16_t *ush, *umla, *g;
  DI void operator()(int rb, int col, const f32x16& v) {
    if (col >= 3488) return;
    bf16_t* dst; int ld; bool lat_only = false;
    if (col < 1792) { dst = ush + col; ld = 1792; }
    else if (col < 2304) { dst = g + (col - 1792); ld = 1024; lat_only = true; }
    else if (col < 2976) { dst = umla + (col - 2304); ld = 672; }
    else { dst = g + 512 + (col - 2976); ld = 1024; lat_only = true; }
#pragma unroll
    for (int i = 0; i < 16; ++i) { int r = rb + (i & 3) + 8 * (i >> 2); if (!lat_only || r < T_LAT) dst[(size_t)r * ld] = f2bf(v[i]); }
  } };
struct EpiLora { bf16_t* dst; const float* bias; int isA;
  DI void operator()(int rb, int col, const f32x16& v) {
    const float bz = bias[col];
    const float sc = isA ? 1.f : 0.6065306597126334f;
#pragma unroll
    for (int i = 0; i < 16; ++i) { int r = rb + (i & 3) + 8 * (i >> 2);
      const float z = bz + v[i];
      const float o = sc * __builtin_amdgcn_rcpf(1.f + __expf(-z));
      dst[(size_t)r * 512 + col] = f2bf(o); }
  } };
struct EpiQ { bf16_t* q;
  DI void operator()(int rb, int col, const f32x16& v) {
    const int h = col / 96, dd = col - h * 96;
    const bool rope = dd >= 64;
    const int cc = dd - 64;
    const int fi = cc & 7; const bool second = (cc & 8) != 0; const bool colaxis = cc >= 16;
    const float invf = exp2f(-(float)fi * (13.287712379549449f / 8.f));
    const float sc = 0.10206207261596577f * 1.4426950408889634f;
#pragma unroll
    for (int i = 0; i < 16; ++i) { int r = rb + (i & 3) + 8 * (i >> 2);
      const int b = r >> 13, t = r & 8191;
      float x = v[i];
      if (rope) {
        float partner = __shfl_xor(x, 8);
        float pos = (float)(colaxis ? (t & 63) : (t >> 6));
        float ang = pos * invf; float cs = __cosf(ang), sn = __sinf(ang);
        x = second ? (partner * sn + x * cs) : (x * cs - partner * sn);
      }
      q[((size_t)(b * 8 + h) * SEQ + t) * 96 + dd] = f2bf(x * sc); }
  } };
struct EpiKV { bf16_t *kn, *vt;
  DI void operator()(int rb, int col, const f32x16& v) {
    const int h = col >> 7, dd = col & 127;
    if (dd < 64) {
#pragma unroll
      for (int i = 0; i < 16; ++i) { int r = rb + (i & 3) + 8 * (i >> 2);
        int b, pos; if (r < T_LAT) { b = r >> 13; pos = r & 8191; } else { b = (r - T_LAT) >> 8; pos = SEQ + ((r - T_LAT) & 255); }
        kn[((size_t)(b * 8 + h) * LK + pos) * 64 + dd] = f2bf(v[i]); }
    } else {
#pragma unroll
      for (int g = 0; g < 4; ++g) {
        const int r = rb + 8 * g;
        int b, pos; if (r < T_LAT) { b = r >> 13; pos = r & 8191; } else { b = (r - T_LAT) >> 8; pos = SEQ + ((r - T_LAT) & 255); }
        const int pp = (pos & ~12) | ((pos & 4) << 1) | ((pos & 8) >> 1);
        *(uint2*)(vt + ((size_t)(b * 8 + h) * 64 + (dd - 64)) * LK + pp) = make_uint2(pack2(v[4 * g], v[4 * g + 1]), pack2(v[4 * g + 2], v[4 * g + 3]));
      }
    }
  } };
struct EpiOut { const float* __restrict__ x; const float* __restrict__ mod; bf16_t* __restrict__ pre;
  DI void operator()(int rb, int col, const f32x16& v) {
    const float gt = mod[(rb >> 13) * 3072 + 2048 + col];
    float xv[16];
#pragma unroll
    for (int i = 0; i < 16; ++i) { const int r = rb + (i & 3) + 8 * (i >> 2); xv[i] = x[(size_t)r * 1024 + col]; }
#pragma unroll
    for (int i = 0; i < 16; ++i) { const int r = rb + (i & 3) + 8 * (i >> 2); pre[(size_t)r * 1024 + col] = f2bf(xv[i] + gt * v[i]); }
  } };

DI void transpose_tile(const float* src, int K, int N, bf16_t* dst, int kt, int nt, float* tile) {
  const int tid = threadIdx.x;
  __syncthreads();
#pragma unroll
  for (int i = 0; i < 8; ++i) { int kk = (tid >> 6) + i * 8, nn = tid & 63; int n = nt * 64 + nn;
    tile[kk * 65 + nn] = (n < N) ? src[(size_t)(kt * 64 + kk) * N + n] : 0.f; }
  __syncthreads();
#pragma unroll
  for (int i = 0; i < 8; ++i) { int nn = (tid >> 6) + i * 8, kk = tid & 63;
    dst[(size_t)(nt * 64 + nn) * K + kt * 64 + kk] = f2bf(tile[kk * 65 + nn]); }
}

DI void phase0(const Params& P, unsigned char* lds) {
  const int tid = threadIdx.x;
  float* fl = (float*)lds;
  const int n_mod = 192, n_win = 16 * 56, n_wout = 256, n_wuq = 72, n_wukv = 64, n_l = 32;
  const int total = n_mod + n_win + n_wout + n_wuq + n_wukv + n_l;
  for (int it = blockIdx.x; it < total; it += gridDim.x) {
    int r = it;
    if (r < n_mod) {
      __syncthreads();
      for (int i = tid; i < 3072; i += NTHR) { int sidx = i >> 10, k = i & 1023; float cv = (sidx == 0) ? P.c[k] : (sidx == 1) ? P.c[1024 + k] : P.c_ctx[k]; fl[i] = siluf(cv); }
      __syncthreads();
      const int cl = tid & 15, kg = tid >> 4, n0 = r * 16;
      float a0 = 0, a1 = 0, a2 = 0;
#pragma unroll 8
      for (int k = kg; k < 1024; k += 32) { float wv = P.ada_w[(size_t)k * 3072 + n0 + cl]; a0 += fl[k] * wv; a1 += fl[1024 + k] * wv; a2 += fl[2048 + k] * wv; }
      __syncthreads();
      fl[4096 + (kg * 3 + 0) * 16 + cl] = a0; fl[4096 + (kg * 3 + 1) * 16 + cl] = a1; fl[4096 + (kg * 3 + 2) * 16 + cl] = a2;
      __syncthreads();
      if (tid < 48) { int sidx = tid >> 4; float sum = 0; for (int qq = 0; qq < 32; ++qq) sum += fl[4096 + (qq * 3 + sidx) * 16 + cl];
        ((float*)(P.ws + OFF_MOD))[sidx * 3072 + n0 + cl] = sum + P.ada_b[n0 + cl]; }
      continue;
    }
    r -= n_mod;
    if (r < n_win) { transpose_tile(P.w_in, 1024, 3488, (bf16_t*)(P.ws + OFF_WIN_T), r / 56, r % 56, fl); continue; }
    r -= n_win;
    if (r < n_wout) { transpose_tile(P.w_out, 1024, 1024, (bf16_t*)(P.ws + OFF_WOUT_T), r / 16, r % 16, fl); continue; }
    r -= n_wout;
    if (r < n_wuq) { transpose_tile(P.w_uq, 384, 768, (bf16_t*)(P.ws + OFF_WUQ_T), r / 12, r % 12, fl); continue; }
    r -= n_wuq;
    if (r < n_wukv) { transpose_tile(P.w_ukv, 256, 1024, (bf16_t*)(P.ws + OFF_WUKV_T), r / 16, r % 16, fl); continue; }
    r -= n_wukv;
    { int g = r >> 3, nt = r & 7; const float* src = (g < 2) ? (P.rw_w2 + (size_t)g * 64 * 512) : (P.rw_a2 + (size_t)(g - 2) * 64 * 512);
      transpose_tile(src, 64, 512, (bf16_t*)(P.ws + OFF_WL_T) + (size_t)g * 512 * 64, 0, nt, fl); }
  }
}

struct Row4 { float4 a, b, c, d; };
DI void row_load(Row4& r, const float* src, int lane) {
  r.a = *(const float4*)(src + lane * 4); r.b = *(const float4*)(src + 256 + lane * 4);
  r.c = *(const float4*)(src + 512 + lane * 4); r.d = *(const float4*)(src + 768 + lane * 4);
}
DI void row_load_nt(Row4& r, const float* src, int lane) {
  typedef float nt4 __attribute__((ext_vector_type(4)));
  const nt4 a = __builtin_nontemporal_load((const nt4*)(src + lane * 4)), b = __builtin_nontemporal_load((const nt4*)(src + 256 + lane * 4));
  const nt4 c = __builtin_nontemporal_load((const nt4*)(src + 512 + lane * 4)), d = __builtin_nontemporal_load((const nt4*)(src + 768 + lane * 4));
  r.a = make_float4(a.x, a.y, a.z, a.w); r.b = make_float4(b.x, b.y, b.z, b.w); r.c = make_float4(c.x, c.y, c.z, c.w); r.d = make_float4(d.x, d.y, d.z, d.w);
}
DI float dot4(const float4& v) { return v.x * v.x + v.y * v.y + v.z * v.z + v.w * v.w; }
DI float row_rstd(const Row4& r) { return rsqrtf(wave_sum(dot4(r.a) + dot4(r.b) + dot4(r.c) + dot4(r.d)) * (1.f / 1024.f) + 1e-6f); }
DI void p1_store(const Params& P, const float* mod, bf16_t* H, int m, const Row4& r, int lane) {
  const int s = (m < T_LAT) ? (m >> 13) : 2;
  const float rstd = row_rstd(r);
  const float4 vv[4] = {r.a, r.b, r.c, r.d};
#pragma unroll
  for (int i = 0; i < 4; ++i) { const int c = i * 256 + lane * 4;
    const float4 g = *(const float4*)(P.norm_g + c), sh = *(const float4*)(mod + s * 3072 + c), sc = *(const float4*)(mod + s * 3072 + 1024 + c);
    const float4 v = vv[i];
    const float o0 = v.x * rstd * g.x * (1.f + sc.x) + sh.x, o1 = v.y * rstd * g.y * (1.f + sc.y) + sh.y;
    const float o2 = v.z * rstd * g.z * (1.f + sc.z) + sh.z, o3 = v.w * rstd * g.w * (1.f + sc.w) + sh.w;
    *(uint2*)(H + (size_t)m * 1024 + c) = make_uint2(pack2(o0, o1), pack2(o2, o3)); }
}
DI void phase1(const Params& P) {
  const int lane = threadIdx.x & 63, gw = blockIdx.x * 8 + (threadIdx.x >> 6), nw = gridDim.x * 8;
  const float* mod = (const float*)(P.ws + OFF_MOD);
  bf16_t* H = (bf16_t*)(P.ws + OFF_H);
#define P1SRC(m) (((m) < T_LAT) ? (P.x + (size_t)(m) * 1024) : (P.ctx + (size_t)((m) - T_LAT) * 1024))
  for (int m = gw; m < T_ALL; m += 4 * nw) {
    const int m1 = m + nw, m2 = m + 2 * nw, m3 = m + 3 * nw;
    Row4 r0, r1, r2, r3;
    row_load_nt(r0, P1SRC(m), lane);
    if (m1 < T_ALL) row_load_nt(r1, P1SRC(m1), lane);
    if (m2 < T_ALL) row_load_nt(r2, P1SRC(m2), lane);
    if (m3 < T_ALL) row_load_nt(r3, P1SRC(m3), lane);
    p1_store(P, mod, H, m, r0, lane);
    if (m1 < T_ALL) p1_store(P, mod, H, m1, r1, lane);
    if (m2 < T_ALL) p1_store(P, mod, H, m2, r2, lane);
    if (m3 < T_ALL) p1_store(P, mod, H, m3, r3, lane);
  }
#undef P1SRC
}

DI void phase2(const Params& P, unsigned char* lds) {
  GemmDesc g{(const bf16_t*)(P.ws + OFF_H), 1024, (const bf16_t*)(P.ws + OFF_WIN_T), 1024, 1024};
  EpiP1 e{(bf16_t*)(P.ws + OFF_USH), (bf16_t*)(P.ws + OFF_UMLA), (bf16_t*)((unsigned char*)P.out + OOFF_G)};
  for (int t = blockIdx.x; t < 66 * 14; t += gridDim.x) gemm_tile(g, (t / 14) * BM, (t % 14) * BN, lds, e);
}

DI void phase3(const Params& P) {
  const int lane = threadIdx.x & 63, gw = blockIdx.x * 8 + (threadIdx.x >> 6), nw = gridDim.x * 8;
  const bf16_t* __restrict__ USH = (const bf16_t*)(P.ws + OFF_USH);
  const bf16_t* __restrict__ UMLA = (const bf16_t*)(P.ws + OFF_UMLA);
  for (int m = gw; m < T_ALL; m += nw) {
    int b, t, len, kpos;
    if (m < T_LAT) { b = m >> 13; t = m & 8191; len = SEQ; kpos = t; } else { b = (m - T_LAT) >> 8; t = (m - T_LAT) & 255; len = CTXL; kpos = SEQ + t; }
    const bool hasp = t > 0, hasn = t < len - 1;
    const uint4 z4 = make_uint4(0, 0, 0, 0);
#pragma unroll
    for (int arr = 0; arr < 3; ++arr) {
      const int col = arr * 512 + lane * 8;
      uint4 cu = *(const uint4*)(USH + (size_t)m * 1792 + col);
      uint4 pu = hasp ? *(const uint4*)(USH + (size_t)(m - 1) * 1792 + col) : z4;
      uint4 nu = hasn ? *(const uint4*)(USH + (size_t)(m + 1) * 1792 + col) : z4;
      float c8[8], p8[8], n8[8], o8[8]; UNPACK8(cu, c8); UNPACK8(pu, p8); UNPACK8(nu, n8);
#pragma unroll
      for (int j = 0; j < 8; ++j) { float mu0 = P.shift_mu[col + j], mu1 = P.shift_mu[1792 + col + j]; o8[j] = c8[j] + mu0 * (p8[j] - c8[j]) + mu1 * (n8[j] - c8[j]); }
      bf16_t* dst = (bf16_t*)(P.ws + OFF_R + arr * SZ_ARR) + (size_t)m * 512 + lane * 8;
      *(uint4*)dst = PACK8(o8);
      if (arr == 1) {
        float k8[8], ss = 0;
#pragma unroll
        for (int j = 0; j < 8; ++j) { k8[j] = o8[j] * P.rw_kk[lane * 8 + j]; ss += k8[j] * k8[j]; }
        ss = sum8(ss);
        const float inv = rsqrtf(fmaxf(ss, 1e-24f));
#pragma unroll
        for (int j = 0; j < 8; ++j) k8[j] *= inv;
        *(uint4*)((bf16_t*)(P.ws + OFF_KK) + (size_t)m * 512 + lane * 8) = PACK8(k8);
      }
    }
    {
      const int col = 1536 + lane * 4;
      uint2 cu = *(const uint2*)(USH + (size_t)m * 1792 + col);
      uint2 pu = hasp ? *(const uint2*)(USH + (size_t)(m - 1) * 1792 + col) : make_uint2(0, 0);
      uint2 nu = hasn ? *(const uint2*)(USH + (size_t)(m + 1) * 1792 + col) : make_uint2(0, 0);
      float c4[4] = {lo16(cu.x), hi16(cu.x), lo16(cu.y), hi16(cu.y)}, p4[4] = {lo16(pu.x), hi16(pu.x), lo16(pu.y), hi16(pu.y)}, n4[4] = {lo16(nu.x), hi16(nu.x), lo16(nu.y), hi16(nu.y)}, o4[4];
#pragma unroll
      for (int j = 0; j < 4; ++j) { float mu0 = P.shift_mu[col + j], mu1 = P.shift_mu[1792 + col + j]; float o = c4[j] + mu0 * (p4[j] - c4[j]) + mu1 * (n4[j] - c4[j]);
        if (lane < 32) { float e2 = __expf(2.f * o); o = 1.f - 2.f / (e2 + 1.f); }
        o4[j] = o; }
      *(uint2*)((bf16_t*)(P.ws + OFF_LW) + (size_t)m * 256 + lane * 4) = make_uint2(pack2(o4[0], o4[1]), pack2(o4[2], o4[3]));
    }
    {
      float x8[8]; float ss = 0;
      if (lane < 48) { uint4 u = *(const uint4*)(UMLA + (size_t)m * 672 + lane * 8); UNPACK8(u, x8);
#pragma unroll
        for (int j = 0; j < 8; ++j) ss += x8[j] * x8[j]; }
      ss = wave_sum(ss);
      const float rstd = rsqrtf(ss * (1.f / 384.f) + 1e-6f);
      if (lane < 48) {
#pragma unroll
        for (int j = 0; j < 8; ++j) x8[j] = x8[j] * rstd * P.q_g[lane * 8 + j];
        *(uint4*)((bf16_t*)(P.ws + OFF_CQ) + (size_t)m * 384 + lane * 8) = PACK8(x8); }
    }
    {
      float x8[8]; float ss = 0;
      if (lane < 32) { uint4 u = *(const uint4*)(UMLA + (size_t)m * 672 + 384 + lane * 8); UNPACK8(u, x8);
#pragma unroll
        for (int j = 0; j < 8; ++j) ss += x8[j] * x8[j]; }
      ss = wave_sum(ss);
      const float rstd = rsqrtf(ss * (1.f / 256.f) + 1e-6f);
      if (lane < 32) {
#pragma unroll
        for (int j = 0; j < 8; ++j) x8[j] = x8[j] * rstd * P.kv_g[lane * 8 + j];
        *(uint4*)((bf16_t*)(P.ws + OFF_CKV) + (size_t)m * 256 + lane * 8) = PACK8(x8); }
    }
    {
      float x8[8];
      const int l4 = lane & 3;
      uint4 u = *(const uint4*)(UMLA + (size_t)m * 672 + 640 + l4 * 8); UNPACK8(u, x8);
      const bool lat = m < T_LAT;
      const float pos = (float)((l4 < 2) ? (t >> 6) : (t & 63));
#pragma unroll
      for (int j = 0; j < 8; ++j) {
        float partner = __shfl_xor(x8[j], 1);
        if (lat) { float ang = pos * exp2f(-(float)j * (13.287712379549449f / 8.f)); float cs = __cosf(ang), sn = __sinf(ang);
          x8[j] = (l4 & 1) ? (partner * sn + x8[j] * cs) : (x8[j] * cs - partner * sn); }
      }
      if (lane < 4) *(uint4*)((bf16_t*)(P.ws + OFF_KR) + ((size_t)b * LK + kpos) * 32 + lane * 8) = PACK8(x8);
    }
  }
}

DI void phase4(const Params& P, unsigned char* lds) {
  const int nl = 4 * 66 * 2, nq = 64 * 3, nkv = 66 * 4;
  for (int it = blockIdx.x; it < nl + nq + nkv; it += gridDim.x) {
    int r = it;
    if (r < nl) { const int g = r / 132, rr = r % 132, tm = rr >> 1, tn = rr & 1; const int d = g & 1, isA = g >> 1;
      GemmDesc gd{(const bf16_t*)(P.ws + OFF_LW) + g * 64, 256, (const bf16_t*)(P.ws + OFF_WL_T) + (size_t)g * 512 * 64, 64, 64};
      EpiLora e{(bf16_t*)(P.ws + (isA ? OFF_A : OFF_E) + d * SZ_ARR), (isA ? P.rw_a0 : P.rw_w0) + d * 512, isA};
      gemm_tile(gd, tm * BM, tn * BN, lds, e); continue; }
    r -= nl;
    if (r < nq) { GemmDesc gd{(const bf16_t*)(P.ws + OFF_CQ), 384, (const bf16_t*)(P.ws + OFF_WUQ_T), 384, 384};
      EpiQ e{(bf16_t*)((unsigned char*)P.out + OOFF_Q)};
      gemm_tile(gd, (r / 3) * BM, (r % 3) * BN, lds, e); continue; }
    r -= nq;
    { GemmDesc gd{(const bf16_t*)(P.ws + OFF_CKV), 256, (const bf16_t*)(P.ws + OFF_WUKV_T), 256, 256};
      EpiKV e{(bf16_t*)(P.ws + OFF_KN), (bf16_t*)(P.ws + OFF_VT)};
      gemm_tile(gd, (r >> 2) * BM, (r & 3) * BN, lds, e); }
  }
}

constexpr int CH = 32, SREC = 352;
constexpr int SCAN_IN_FLOATS = 2 * CH * SREC, SCAN_Y_FLOATS = 2 * CH * 32;
constexpr int LDS_BYTES = 2 * (256 + 256) * 72 * 2 + 256;
static_assert(LDS_BYTES >= (SCAN_IN_FLOATS + SCAN_Y_FLOATS + 2 * 16 * CH) * 4 + 256, "lds scan");
template <int CTRL> DI float dppf(float v) { return __int_as_float(__builtin_amdgcn_update_dpp(0, __float_as_int(v), CTRL, 0xf, 0xf, false)); }
DI float red8(float p) { p += dppf<0xB1>(p); p += dppf<0x4E>(p); p += dppf<0x141>(p); return p; }
DI float red16(float p) { p += dppf<0xB1>(p); p += dppf<0x4E>(p); p += dppf<0x141>(p); p += dppf<0x140>(p); return p; }
struct StepOps { float4 a, b, w, k, r; };
DI void ld_ops(StepOps& o, const float* rec, int q4) {
  o.a = *(const float4*)(rec + q4);
  o.b = *(const float4*)(rec + 64 + q4);
  o.w = *(const float4*)(rec + 128 + q4);
  o.k = *(const float4*)(rec + 192 + q4);
  o.r = *(const float4*)(rec + 256 + q4);
}

DI void scan_task(const Params& P, int sb, unsigned char* lds) {
  const int qtr = sb & 3, h = (sb >> 2) & 7, b = (sb >> 5) & 1, d = sb >> 6;
  const int tid = threadIdx.x, lane = tid & 63, w = __builtin_amdgcn_readfirstlane(tid >> 6);
  float* buf = (float*)lds;
  float* ybuf = buf + SCAN_IN_FLOATS;
  float* vtb = ybuf + SCAN_Y_FLOATS;
  const bf16_t* R = (const bf16_t*)(P.ws + OFF_R); const bf16_t* K = (const bf16_t*)(P.ws + OFF_K);
  const bf16_t* V = (const bf16_t*)(P.ws + OFF_V); const bf16_t* KKp = (const bf16_t*)(P.ws + OFF_KK);
  const bf16_t* Ad = (const bf16_t*)(P.ws + OFF_A + d * SZ_ARR); const bf16_t* Ed = (const bf16_t*)(P.ws + OFF_E + d * SZ_ARR);
  bf16_t* Yf = (bf16_t*)(P.ws + OFF_MIX); bf16_t* Yb = (bf16_t*)(P.ws + OFF_YB);
  const int NCH = LK / CH;
  __syncthreads();
  if (w >= 4) {
    const int lt = tid - 256, tok = lt >> 3, cgp = lt & 7, col = h * 64 + cgp * 8;
    float ka[8];
#pragma unroll
    for (int j = 0; j < 8; ++j) ka[j] = P.rw_ka[col + j];
    uint4 urA, ukA, ukkA, uaA, ueA, uvA = make_uint4(0, 0, 0, 0), urB, ukB, ukkB, uaB, ueB, uvB = make_uint4(0, 0, 0, 0);
#define RAWLOAD(cc, X) do { \
      const int s_ = (cc) * CH + tok; int m_; \
      if (s_ < CTXL) { int tc = d ? (CTXL - 1 - s_) : s_; m_ = T_LAT + b * CTXL + tc; } else { int u_ = s_ - CTXL; int t_ = d ? (SEQ - 1 - u_) : u_; m_ = b * SEQ + t_; } \
      const size_t off = (size_t)m_ * 512 + col; \
      ur##X = *(const uint4*)(R + off); uk##X = *(const uint4*)(K + off); ukk##X = *(const uint4*)(KKp + off); ua##X = *(const uint4*)(Ad + off); ue##X = *(const uint4*)(Ed + off); \
      if (cgp < 2) uv##X = *(const uint4*)(V + (size_t)m_ * 512 + h * 64 + qtr * 16 + cgp * 8); } while (0)
#define CONVSTORE(cc, X) do { \
      float r8[8], k8[8], kk8[8], a8[8], e8[8], v8[8]; UNPACK8(ur##X, r8); UNPACK8(uk##X, k8); UNPACK8(ukk##X, kk8); UNPACK8(ua##X, a8); UNPACK8(ue##X, e8); UNPACK8(uv##X, v8); \
      float* dst = buf + ((cc) & 1) * (CH * SREC) + tok * SREC; \
      float na[8], bd[8], wd[8], kd[8]; \
      _Pragma("unroll") for (int j = 0; j < 8; ++j) { na[j] = -kk8[j]; bd[j] = kk8[j] * a8[j]; wd[j] = __expf(-e8[j]); kd[j] = k8[j] * (1.f + (a8[j] - 1.f) * ka[j]); } \
      *(float4*)(dst + cgp * 8) = make_float4(na[0], na[1], na[2], na[3]); *(float4*)(dst + cgp * 8 + 4) = make_float4(na[4], na[5], na[6], na[7]); \
      *(float4*)(dst + 64 + cgp * 8) = make_float4(bd[0], bd[1], bd[2], bd[3]); *(float4*)(dst + 64 + cgp * 8 + 4) = make_float4(bd[4], bd[5], bd[6], bd[7]); \
      *(float4*)(dst + 128 + cgp * 8) = make_float4(wd[0], wd[1], wd[2], wd[3]); *(float4*)(dst + 128 + cgp * 8 + 4) = make_float4(wd[4], wd[5], wd[6], wd[7]); \
      *(float4*)(dst + 192 + cgp * 8) = make_float4(kd[0], kd[1], kd[2], kd[3]); *(float4*)(dst + 192 + cgp * 8 + 4) = make_float4(kd[4], kd[5], kd[6], kd[7]); \
      *(float4*)(dst + 256 + cgp * 8) = make_float4(r8[0], r8[1], r8[2], r8[3]); *(float4*)(dst + 256 + cgp * 8 + 4) = make_float4(r8[4], r8[5], r8[6], r8[7]); \
      if (cgp < 2) { float* vt_ = vtb + ((cc) & 1) * (16 * CH) + (cgp * 8) * CH + tok; \
        _Pragma("unroll") for (int j = 0; j < 8; ++j) vt_[j * CH] = v8[j]; } \
    } while (0)
#define YFLUSH(cc) do { \
      const int u_ = (cc) * CH + tok - CTXL; const int t_ = d ? (SEQ - 1 - u_) : u_; \
      const float2 yv = *(const float2*)(ybuf + ((cc) & 1) * (CH * 16) + tok * 16 + cgp * 2); \
      const size_t mrow = (size_t)b * SEQ + t_; const int cc_ = h * 64 + qtr * 16 + cgp * 2; \
      if (d == 0) *(unsigned*)(Yf + mrow * 1024 + cc_) = pack2(yv.x, yv.y); else *(unsigned*)(Yb + mrow * 512 + cc_) = pack2(yv.x, yv.y); } while (0)
    RAWLOAD(0, A); CONVSTORE(0, A); RAWLOAD(1, A); RAWLOAD(2, B);
    __syncthreads();
    for (int c = 0; c < NCH; c += 2) {
      if (c + 1 < NCH) CONVSTORE(c + 1, A);
      if (c + 3 < NCH) RAWLOAD(c + 3, A);
      if (c - 1 >= CTXL / CH) YFLUSH(c - 1);
      __syncthreads();
      if (c + 2 < NCH) CONVSTORE(c + 2, B);
      if (c + 4 < NCH) RAWLOAD(c + 4, B);
      if (c >= CTXL / CH) YFLUSH(c);
      __syncthreads();
    }
    YFLUSH(NCH - 1);
#undef RAWLOAD
#undef CONVSTORE
#undef YFLUSH
  } else {
    const int q = lane & 15, q4 = q * 4, rowl = w * 4 + (lane >> 4);
    const bool o1 = (lane & 1) != 0, o2 = (lane & 2) != 0;
    f2 S0 = {0.f, 0.f}, S1 = {0.f, 0.f};
    __syncthreads();
    for (int c = 0; c < NCH; ++c) {
      const float* cb = buf + (c & 1) * (CH * SREC);
      const float* vrow = vtb + (c & 1) * (16 * CH) + rowl * CH;
      float* yb = ybuf + (c & 1) * (CH * 16);
      StepOps cur, nxt, nx2, nx3;
      ld_ops(cur, cb, q4);
      ld_ops(nxt, cb + SREC, q4);
      ld_ops(nx2, cb + 2 * SREC, q4);
#pragma unroll 1
      for (int g4 = 0; g4 < CH / 4; ++g4) {
        const float* gb = cb + g4 * 4 * SREC;
        const float4 v4 = *(const float4*)(vrow + g4 * 4);
        float pp[4];
#pragma unroll
        for (int i = 0; i < 4; ++i) {
          ld_ops(nx3, gb + (i + 3) * SREC, q4);
          const f2 a01 = {cur.a.x, cur.a.y}, a23 = {cur.a.z, cur.a.w}, w01 = {cur.w.x, cur.w.y}, w23 = {cur.w.z, cur.w.w};
          const f2 k01 = {cur.k.x, cur.k.y}, k23 = {cur.k.z, cur.k.w}, b01 = {cur.b.x, cur.b.y}, b23 = {cur.b.z, cur.b.w};
          const f2 r01 = {cur.r.x, cur.r.y}, r23 = {cur.r.z, cur.r.w};
          f2 pa = S0 * a01; pa += S1 * a23;
          const float vs = (i == 0) ? v4.x : (i == 1) ? v4.y : (i == 2) ? v4.z : v4.w;
          const f2 vv = {vs, vs};
          const f2 t0 = S0 * w01 + vv * k01, t1 = S1 * w23 + vv * k23;
          const float sa = red16(pa.x + pa.y);
          const f2 sa2 = {sa, sa};
          S0 = t0 + sa2 * b01; S1 = t1 + sa2 * b23;
          f2 py = S0 * r01; py += S1 * r23;
          pp[i] = py.x + py.y;
          cur = nxt; nxt = nx2; nx2 = nx3;
        }
        const float tA = o1 ? pp[0] : pp[1], kA = o1 ? pp[1] : pp[0];
        const float tB = o1 ? pp[2] : pp[3], kB = o1 ? pp[3] : pp[2];
        const float r0 = kA + dppf<0xB1>(tA), r1 = kB + dppf<0xB1>(tB);
        const float tC = o2 ? r0 : r1, kC = o2 ? r1 : r0;
        float u = kC + dppf<0x4E>(tC);
        u += dppf<0x124>(u);
        u += dppf<0x128>(u);
        yb[(g4 * 4 + (q & 3)) * 16 + rowl] = u;
      }
      __syncthreads();
    }
  }
}

constexpr int AK_LD = 104, AV_LD = 72, ABUF = 64 * AK_LD * 2 + 64 * AV_LD * 2;
DI void attn_item(const Params& P, int item, unsigned char* lds) {
  const int qb = item & 15, h = (item >> 4) & 7, b = item >> 7;
  int tid = threadIdx.x; asm volatile("" : "+v"(tid));
  const int lane = tid & 63, w = tid >> 6, l31 = lane & 31, hh = lane >> 5;
  const bf16_t* Q = (const bf16_t*)((const unsigned char*)P.out + OOFF_Q) + ((size_t)(b * 8 + h) * SEQ + qb * 512 + w * 64) * 96;
  const bf16_t* KN = (const bf16_t*)(P.ws + OFF_KN) + (size_t)(b * 8 + h) * LK * 64;
  const bf16_t* KR = (const bf16_t*)(P.ws + OFF_KR) + (size_t)b * LK * 32;
  const bf16_t* VT = (const bf16_t*)(P.ws + OFF_VT) + (size_t)(b * 8 + h) * 64 * LK;
  bf16x8 qa0, qa1, qa2, qa3, qa4, qa5, qb0, qb1, qb2, qb3, qb4, qb5;
  { const bf16_t* q0 = Q + (size_t)l31 * 96 + hh * 8; const bf16_t* q1 = q0 + 32 * 96;
    qa0 = *(const bf16x8*)(q0); qa1 = *(const bf16x8*)(q0 + 16); qa2 = *(const bf16x8*)(q0 + 32); qa3 = *(const bf16x8*)(q0 + 48); qa4 = *(const bf16x8*)(q0 + 64); qa5 = *(const bf16x8*)(q0 + 80);
    qb0 = *(const bf16x8*)(q1); qb1 = *(const bf16x8*)(q1 + 16); qb2 = *(const bf16x8*)(q1 + 32); qb3 = *(const bf16x8*)(q1 + 48); qb4 = *(const bf16x8*)(q1 + 64); qb5 = *(const bf16x8*)(q1 + 80); }
  f32x16 O00, O01, O10, O11;
#pragma unroll
  for (int e = 0; e < 16; ++e) { O00[e] = 0.f; O01[e] = 0.f; O10[e] = 0.f; O11[e] = 0.f; }
  float m0 = -1e30f, l0 = 0.f, m1 = -1e30f, l1 = 0.f;
  constexpr int KB = 64 * AK_LD, VB = 64 * AV_LD;
  bf16_t* Kl = (bf16_t*)lds; bf16_t* Vl = Kl + 2 * KB;
  uint4 rk, rr = make_uint4(0, 0, 0, 0), rv;
#define TLOAD(kt) do { const int key0 = (kt) * 64; \
    rk = *(const uint4*)(KN + (size_t)(key0 + (tid >> 3)) * 64 + (tid & 7) * 8); \
    if (tid < 256) rr = *(const uint4*)(KR + (size_t)(key0 + (tid >> 2)) * 32 + (tid & 3) * 8); \
    rv = *(const uint4*)(VT + (size_t)(tid >> 3) * LK + key0 + (tid & 7) * 8); } while (0)
#define TSTORE(st) do { bf16_t* Ks = Kl + (st) * KB; \
    *(uint4*)(Ks + (tid >> 3) * AK_LD + (tid & 7) * 8) = rk; \
    if (tid < 256) *(uint4*)(Ks + (tid >> 2) * AK_LD + 64 + (tid & 3) * 8) = rr; \
    *(uint4*)(Vl + (st) * VB + (tid >> 3) * AV_LD + (tid & 7) * 8) = rv; } while (0)
#define MF(a, b, c) __builtin_amdgcn_mfma_f32_32x32x16_bf16((a), (b), (c), 0, 0, 0)
#define SOFTMAX(sa, sb, m, l, Oa, Ob) do { \
    float mloc = sa[0]; \
    _Pragma("unroll") for (int e = 1; e < 16; ++e) mloc = fmaxf(mloc, sa[e]); \
    _Pragma("unroll") for (int e = 0; e < 16; ++e) mloc = fmaxf(mloc, sb[e]); \
    mloc = xhalf_max(mloc); \
    if (__builtin_amdgcn_ballot_w64(mloc > m) != 0ull) { \
      const float mnew = fmaxf(m, mloc); const float alpha = __builtin_amdgcn_exp2f(m - mnew); \
      m = mnew; l *= alpha; \
      _Pragma("unroll") for (int e = 0; e < 16; ++e) { Oa[e] *= alpha; Ob[e] *= alpha; } } \
    float pa = 0.f, pb = 0.f; \
    _Pragma("unroll") for (int e = 0; e < 16; ++e) { sa[e] = __builtin_amdgcn_exp2f(sa[e] - m); pa += sa[e]; sb[e] = __builtin_amdgcn_exp2f(sb[e] - m); pb += sb[e]; } \
    l += pa + pb; } while (0)
#define PK8(sv, o) make_uint4(pack2(sv[(o) + 0], sv[(o) + 1]), pack2(sv[(o) + 2], sv[(o) + 3]), pack2(sv[(o) + 4], sv[(o) + 5]), pack2(sv[(o) + 6], sv[(o) + 7]))
  const int NKT = LK / 64;
  __syncthreads();
  TLOAD(0); TSTORE(0);
  __syncthreads();
  for (int kt = 0; kt < NKT; ++kt) {
    { const int k1 = (kt + 1 < NKT) ? kt + 1 : NKT - 1; TLOAD(k1); }
    const bf16_t* Ks = Kl + (kt & 1) * KB; const bf16_t* Vs = Vl + (kt & 1) * VB;
    f32x16 s00, s01, s10, s11;
#pragma unroll
    for (int e = 0; e < 16; ++e) { s00[e] = 0.f; s01[e] = 0.f; s10[e] = 0.f; s11[e] = 0.f; }
    const bf16_t* kp = Ks + l31 * AK_LD + hh * 8;
#define QKSTEP(off, qa, qbb) do { const bf16x8 a0 = *(const bf16x8*)(kp + (off)), a1 = *(const bf16x8*)(kp + 32 * AK_LD + (off)); \
      s00 = MF(a0, qa, s00); s01 = MF(a1, qa, s01); s10 = MF(a0, qbb, s10); s11 = MF(a1, qbb, s11); } while (0)
    QKSTEP(0, qa0, qb0); QKSTEP(16, qa1, qb1); QKSTEP(32, qa2, qb2); QKSTEP(48, qa3, qb3); QKSTEP(64, qa4, qb4); QKSTEP(80, qa5, qb5);
#undef QKSTEP
    SOFTMAX(s00, s01, m0, l0, O00, O01);
    SOFTMAX(s10, s11, m1, l1, O10, O11);
    const bf16_t* vp = Vs + l31 * AV_LD + 8 * hh;
#define PVSTEP(sx, sy, o, koff) do { union { uint4 u; bf16x8 v; } p0, p1; p0.u = PK8(sx, o); p1.u = PK8(sy, o); \
      const bf16x8 v0 = *(const bf16x8*)(vp + (koff)), v1 = *(const bf16x8*)(vp + 32 * AV_LD + (koff)); \
      O00 = MF(v0, p0.v, O00); O01 = MF(v1, p0.v, O01); O10 = MF(v0, p1.v, O10); O11 = MF(v1, p1.v, O11); } while (0)
    PVSTEP(s00, s10, 0, 0); PVSTEP(s00, s10, 8, 16); PVSTEP(s01, s11, 0, 32); PVSTEP(s01, s11, 8, 48);
#undef PVSTEP
    TSTORE((kt + 1) & 1);
    __syncthreads();
  }
#undef TLOAD
#undef TSTORE
#undef SOFTMAX
#undef PK8
  const bf16_t* __restrict__ G = (const bf16_t*)((const unsigned char*)P.out + OOFF_G);
  bf16_t* __restrict__ MIX = (bf16_t*)(P.ws + OFF_MIX);
  int l31e = l31; asm volatile("" : "+v"(l31e));
#define AEPI(Oa, Ob, l, qt) do { \
    const float inv = 1.f / (l + __shfl_xor(l, 32)); \
    const int t = qb * 512 + w * 64 + (qt) * 32 + l31e; \
    const size_t rowoff = ((size_t)b * SEQ + t) * 1024 + 512 + h * 64; \
    _Pragma("unroll") for (int g4 = 0; g4 < 4; ++g4) { \
      const int dv = 8 * g4 + 4 * hh; \
      const uint2 ga = *(const uint2*)(G + rowoff + dv), gb = *(const uint2*)(G + rowoff + 32 + dv); \
      *(uint2*)(MIX + rowoff + dv) = make_uint2(pack2(Oa[4 * g4 + 0] * inv * siluf(lo16(ga.x)), Oa[4 * g4 + 1] * inv * siluf(hi16(ga.x))), \
                                                pack2(Oa[4 * g4 + 2] * inv * siluf(lo16(ga.y)), Oa[4 * g4 + 3] * inv * siluf(hi16(ga.y)))); \
      *(uint2*)(MIX + rowoff + 32 + dv) = make_uint2(pack2(Ob[4 * g4 + 0] * inv * siluf(lo16(gb.x)), Ob[4 * g4 + 1] * inv * siluf(hi16(gb.x))), \
                                                     pack2(Ob[4 * g4 + 2] * inv * siluf(lo16(gb.y)), Ob[4 * g4 + 3] * inv * siluf(hi16(gb.y)))); } } while (0)
  AEPI(O00, O01, l0, 0);
  AEPI(O10, O11, l1, 1);
#undef AEPI
#undef MF
}

DI unsigned xb_xcc_id();
DI void phase5(const Params& P, unsigned char* lds, int ctr_idx = 0) {
  int* sh_item = (int*)(lds + LDS_BYTES - 64);
  const int bx = (int)blockIdx.x;
  if ((int)gridDim.x == 2 * NSCAN) { if ((bx & 4) == 0) scan_task(P, (bx & 3) * 32 + (bx >> 3), lds); }
  else if (bx < NSCAN && (int)gridDim.x > NSCAN) scan_task(P, bx, lds);
  else if ((int)gridDim.x <= NSCAN) { for (int sb = bx; sb < NSCAN; sb += gridDim.x) scan_task(P, sb, lds); }
  int* ctr = (int*)(P.ws + OFF_CTR) + ctr_idx * 8;
  const int q0 = (int)(xb_xcc_id() & 3u);
  for (;;) {
    __syncthreads();
    if (threadIdx.x == 0) {
      int item = -1;
      for (int k = 0; k < 4; ++k) { const int q = (q0 + k) & 3; const int j = atomicAdd(ctr + q, 1); if (j < 64) { item = q * 64 + j; break; } }
      *sh_item = item;
    }
    __syncthreads();
    const int item = *sh_item;
    if (item < 0) break;
    attn_item(P, item, lds);
  }
}

DI void phase6(const Params& P) {
  const int lane = threadIdx.x & 63, gw = blockIdx.x * 8 + (threadIdx.x >> 6), nw = gridDim.x * 8;
  bf16_t* MIX = (bf16_t*)(P.ws + OFF_MIX);
  const bf16_t* YB = (const bf16_t*)(P.ws + OFF_YB);
  const bf16_t* G = (const bf16_t*)((const unsigned char*)P.out + OOFF_G);
  const int c0 = lane * 8;
  for (int m = gw; m < T_LAT; m += nw) {
    float yf[8], yb[8], y[8], r8[8], k8[8], v8[8], a0[8], a1[8], g8[8], o8[8];
    uint4 u;
    u = *(const uint4*)(MIX + (size_t)m * 1024 + c0); UNPACK8(u, yf);
    u = *(const uint4*)(YB + (size_t)m * 512 + c0); UNPACK8(u, yb);
    u = *(const uint4*)((const bf16_t*)(P.ws + OFF_R) + (size_t)m * 512 + c0); UNPACK8(u, r8);
    u = *(const uint4*)((const bf16_t*)(P.ws + OFF_K) + (size_t)m * 512 + c0); UNPACK8(u, k8);
    u = *(const uint4*)((const bf16_t*)(P.ws + OFF_V) + (size_t)m * 512 + c0); UNPACK8(u, v8);
    u = *(const uint4*)((const bf16_t*)(P.ws + OFF_A) + (size_t)m * 512 + c0); UNPACK8(u, a0);
    u = *(const uint4*)((const bf16_t*)(P.ws + OFF_A + SZ_ARR) + (size_t)m * 512 + c0); UNPACK8(u, a1);
    u = *(const uint4*)(G + (size_t)m * 1024 + c0); UNPACK8(u, g8);
    float sm = 0, bon = 0;
#pragma unroll
    for (int j = 0; j < 8; ++j) { y[j] = yf[j] + yb[j]; sm += y[j];
      const float ka = P.rw_ka[c0 + j];
      const float kds = k8[j] * (2.f + (a0[j] + a1[j] - 2.f) * ka);
      bon += r8[j] * kds * P.rw_rk[c0 + j]; }
    sm = sum8(sm); bon = sum8(bon);
    const float mean = sm * (1.f / 64.f);
    float vs = 0;
#pragma unroll
    for (int j = 0; j < 8; ++j) { float dlt = y[j] - mean; vs += dlt * dlt; }
    vs = sum8(vs);
    const float rstd = rsqrtf(vs * (1.f / 64.f) + 64e-5f);
#pragma unroll
    for (int j = 0; j < 8; ++j) { float yn = (y[j] - mean) * rstd * P.lnx_g[c0 + j] + P.lnx_b[c0 + j]; o8[j] = (yn + bon * v8[j]) * siluf(g8[j]); }
    *(uint4*)(MIX + (size_t)m * 1024 + c0) = PACK8(o8);
  }
}

DI void phase7(const Params& P, unsigned char* lds) {
  GemmDesc g{(const bf16_t*)(P.ws + OFF_MIX), 1024, (const bf16_t*)(P.ws + OFF_WOUT_T), 1024, 1024};
  EpiOut e{P.x, (const float*)(P.ws + OFF_MOD), (bf16_t*)(P.ws + OFF_X1)};
  for (int t = blockIdx.x; t < 64 * 4; t += gridDim.x) gemm_tile(g, (t >> 2) * BM, (t & 3) * BN, lds, e);
}

DI void p8_store(const Params& P, float* row, const Row4& r, int lane) {
  const float rstd = row_rstd(r);
  const float4 vv[4] = {r.a, r.b, r.c, r.d};
#pragma unroll
  for (int i = 0; i < 4; ++i) { const int c = i * 256 + lane * 4; const float4 g = *(const float4*)(P.final_g + c); const float4 v = vv[i];
    typedef float nt4 __attribute__((ext_vector_type(4)));
    nt4 o = {v.x * rstd * g.x, v.y * rstd * g.y, v.z * rstd * g.z, v.w * rstd * g.w};
    __builtin_nontemporal_store(o, (nt4*)(row + c)); }
}
DI void row_load_bf(Row4& r, const bf16_t* src, int lane) {
  const uint2 a = *(const uint2*)(src + lane * 4), b = *(const uint2*)(src + 256 + lane * 4), c = *(const uint2*)(src + 512 + lane * 4), d = *(const uint2*)(src + 768 + lane * 4);
  r.a = make_float4(lo16(a.x), hi16(a.x), lo16(a.y), hi16(a.y)); r.b = make_float4(lo16(b.x), hi16(b.x), lo16(b.y), hi16(b.y));
  r.c = make_float4(lo16(c.x), hi16(c.x), lo16(c.y), hi16(c.y)); r.d = make_float4(lo16(d.x), hi16(d.x), lo16(d.y), hi16(d.y));
}
DI void phase8(const Params& P) {
  const bf16_t* PRE = (const bf16_t*)(P.ws + OFF_X1);
  const int lane = threadIdx.x & 63, gw = blockIdx.x * 8 + (threadIdx.x >> 6), nw = gridDim.x * 8;
  for (int m = gw; m < T_LAT; m += 4 * nw) {
    const int m1 = m + nw, m2 = m + 2 * nw, m3 = m + 3 * nw;
    Row4 r0, r1, r2, r3;
    row_load_bf(r0, PRE + (size_t)m * 1024, lane);
    if (m1 < T_LAT) row_load_bf(r1, PRE + (size_t)m1 * 1024, lane);
    if (m2 < T_LAT) row_load_bf(r2, PRE + (size_t)m2 * 1024, lane);
    if (m3 < T_LAT) row_load_bf(r3, PRE + (size_t)m3 * 1024, lane);
    p8_store(P, P.out + (size_t)m * 1024, r0, lane);
    if (m1 < T_LAT) p8_store(P, P.out + (size_t)m1 * 1024, r1, lane);
    if (m2 < T_LAT) p8_store(P, P.out + (size_t)m2 * 1024, r2, lane);
    if (m3 < T_LAT) p8_store(P, P.out + (size_t)m3 * 1024, r3, lane);
  }
}

static_assert(LDS_BYTES >= 2 * ABUF + 16 && LDS_BYTES >= 2 * (BM + BN) * LDT * 2 && LDS_BYTES >= 4096 * 4 + 24 * 64 * 4, "lds");

#define XB_TMO      128
#define XB_XCNT(j)  (256  + 64 * (j))
#define XB_XSUB(j)  (1280 + 64 * (j))
#define XB_XGEN(j)  (2304 + 64 * (j))
#define XB_TOP      3328
#define XB_TOPGEN   3392
#define XCD_BAR_WORDS 3456
#define XB_SPIN_CAP (1u << 20)
DI unsigned xb_ld(unsigned* p) { return __hip_atomic_load(p, __ATOMIC_RELAXED, __HIP_MEMORY_SCOPE_AGENT); }
DI unsigned xb_add(unsigned* p, unsigned v) { return __hip_atomic_fetch_add(p, v, __ATOMIC_RELAXED, __HIP_MEMORY_SCOPE_AGENT); }
DI unsigned xb_xcc_id() { return (unsigned)__builtin_amdgcn_s_getreg((3 << 11) | 20) & 0xFu; }
#define XB_SPIN(cond, bar) do { unsigned _sp = 0; while (cond) { __builtin_amdgcn_s_sleep(1); \
    if ((++_sp & 255u) == 0u) { if (xb_ld(&(bar)[XB_TMO])) break; if (_sp > XB_SPIN_CAP) { atomicAdd(&(bar)[XB_TMO], 1u); break; } } } } while (0)
struct XcdBarrier { unsigned* bar; unsigned x; volatile unsigned* st; };
DI void xcd_barrier_complete(unsigned* bar, unsigned x, unsigned& nloc, unsigned& nx) {
  const unsigned G = gridDim.x;
  unsigned sum, cnt, mine, sp = 0u;
  for (;;) {
    sum = 0u; cnt = 0u; mine = 0u;
#pragma unroll
    for (unsigned j = 0; j < 16; ++j) { const unsigned c = xb_ld(&bar[XB_XCNT(j)]); sum += c; cnt += (c > 0u) ? 1u : 0u; mine = (j == x) ? c : mine; }
    if (sum == G) break;
    __builtin_amdgcn_s_sleep(1);
    if ((++sp & 255u) == 0u) { if (xb_ld(&bar[XB_TMO])) break; if (sp > XB_SPIN_CAP) { atomicAdd(&bar[XB_TMO], 1u); break; } }
  }
  nloc = mine > 0u ? mine : 1u; nx = cnt > 0u ? cnt : 1u;
}
DI void xcd_barrier(const XcdBarrier& b) {
  asm volatile("s_waitcnt vmcnt(0)" ::: "memory");
  __syncthreads();
  if (threadIdx.x == 0) {
    unsigned* bar = b.bar;
    __builtin_amdgcn_s_waitcnt(0);
    unsigned nloc = b.st[0], nx = b.st[1];
    if (nloc == 0u) { xcd_barrier_complete(bar, b.x, nloc, nx); b.st[0] = nloc; b.st[1] = nx; }
    const unsigned old = xb_add(&bar[XB_XSUB(b.x)], 1u);
    const unsigned gen = old / nloc;
    if (old + 1u == (gen + 1u) * nloc) {
      __builtin_amdgcn_fence(__ATOMIC_RELEASE, "agent");
      asm volatile("s_waitcnt vmcnt(0)" ::: "memory");
      const unsigned og = xb_add(&bar[XB_TOP], 1u);
      const unsigned tg = og / nx;
      if (og + 1u == (tg + 1u) * nx) xb_add(&bar[XB_TOPGEN], 1u);
      else XB_SPIN(xb_ld(&bar[XB_TOPGEN]) == tg, bar);
      __builtin_amdgcn_fence(__ATOMIC_ACQUIRE, "agent");
      xb_add(&bar[XB_XGEN(b.x)], 1u);
      asm volatile("s_waitcnt vmcnt(0)" ::: "memory");
    } else {
      XB_SPIN(xb_ld(&bar[XB_XGEN(b.x)]) == gen, bar);
      __builtin_amdgcn_fence(__ATOMIC_ACQUIRE, "agent");
      asm volatile("s_waitcnt vmcnt(0)" ::: "memory");
    }
  }
  __syncthreads();
}

__global__ void __launch_bounds__(NTHR) mega(Params P) {
  __shared__ __attribute__((aligned(16))) unsigned char lds[LDS_BYTES];
  const int lo = P.ph_lo, hi = P.ph_hi;
  __shared__ unsigned bar_st[4];
  if (threadIdx.x < 4) bar_st[threadIdx.x] = 0u;
  __syncthreads();
  XcdBarrier xbar; xbar.bar = (unsigned*)(P.ws + OFF_BAR); xbar.x = xb_xcc_id(); xbar.st = bar_st;
  if (hi - lo > 1 && threadIdx.x == 0) (void)xb_add(&xbar.bar[XB_XCNT(xbar.x)], 1u);
  if (lo < 0) cg::this_grid().sync();
#define GSYNC() xcd_barrier(xbar)
#define PH(k, call) if (lo <= (k) && (k) < hi) { call; if ((k) + 1 < hi) GSYNC(); }
  PH(0, phase0(P, lds))
  PH(1, phase1(P))
#if PROBE == 9
  phase1(P); cg::this_grid().sync();
#elif PROBE == 10
  for (int i = 0; i < 8; ++i) GSYNC();
#endif
  PH(2, phase2(P, lds))
#if PROBE == 3
  phase2(P, lds); GSYNC();
#endif
  PH(3, phase3(P))
#if PROBE == 4
  phase3(P); GSYNC();
#endif
  PH(4, phase4(P, lds))
#if PROBE == 5
  phase4(P, lds); GSYNC();
#endif
  PH(5, phase5(P, lds))
#if PROBE == 6
  phase5(P, lds, 1); cg::this_grid().sync();
#elif PROBE == 7
  phase0(P, lds); cg::this_grid().sync();
#elif PROBE == 1
  cg::this_grid().sync(); if ((int)blockIdx.x < NSCAN) scan_task(P, blockIdx.x, lds); cg::this_grid().sync();
#elif PROBE == 2
  cg::this_grid().sync(); for (int it = blockIdx.x; it < 256; it += gridDim.x) attn_item(P, it, lds); GSYNC();
#endif
  PH(6, phase6(P))
  PH(7, phase7(P, lds))
#if PROBE == 8
  phase7(P, lds); GSYNC();
#endif
  PH(8, phase8(P))
#undef PH
}

extern "C" void kernel_launch(void* const* d_in, const int* in_sizes, int n_in, void* d_out, int out_size, void* d_ws, size_t ws_size, hipStream_t stream) {
  static int grid_blocks = 0;
  if (!grid_blocks) {
    int dev = 0, cus = 0, per_cu = 0;
    hipGetDevice(&dev);
    hipDeviceGetAttribute(&cus, hipDeviceAttributeMultiprocessorCount, dev);
    hipOccupancyMaxActiveBlocksPerMultiprocessor(&per_cu, mega, NTHR, 0);
    if (per_cu < 1) per_cu = 1;
    grid_blocks = cus * per_cu;
    if (ws_size < WS_END) fprintf(stderr, "workspace too small: %zu < %zu\n", ws_size, (size_t)WS_END);
  }
  Params p{};
  const float** pp = (const float**)&p;
  for (int i = 0; i < 24; ++i) pp[i] = (const float*)d_in[i];
  p.out = (float*)d_out; p.ws = (unsigned char*)d_ws;
  hipMemsetAsync((unsigned char*)d_ws + OFF_CTR, 0, (OFF_BAR - OFF_CTR) + XCD_BAR_WORDS * 4, stream);
#if ONE_LAUNCH
  p.ph_lo = 0; p.ph_hi = NPHASE;
  void* args[] = {&p};
  hipError_t e = hipLaunchCooperativeKernel((void*)mega, dim3(grid_blocks), dim3(NTHR), args, 0, stream);
  if (e != hipSuccess) fprintf(stderr, "cooperative launch failed: %s (grid %d)\n", hipGetErrorString(e), grid_blocks);
#else
  for (int ph = 0; ph < NPHASE; ++ph) { p.ph_lo = ph; p.ph_hi = ph + 1; hipLaunchKernelGGL(mega, dim3(grid_blocks), dim3(NTHR), 0, stream, p); }
#endif
}
```

```cpp
#include <hip/hip_runtime.h>
#include <hip/hip_cooperative_groups.h>
#include <stdint.h>
#include <stdio.h>
namespace cg = cooperative_groups;

#ifndef PROBE
#define PROBE 0
#endif
#ifndef ONE_LAUNCH
#define ONE_LAUNCH 1
#endif

#define DI __device__ __forceinline__
typedef unsigned short bf16_t;
using bf16x8 = __attribute__((ext_vector_type(8))) short;
using f32x16 = __attribute__((ext_vector_type(16))) float;
using f2 = __attribute__((ext_vector_type(2))) float;

constexpr int T_LAT = 16384, T_ALL = 16896, SEQ = 8192, CTXL = 256, LK = 8448;
constexpr int NTHR = 512;
constexpr int NPHASE = 9;
constexpr int NSCAN = 128;

constexpr size_t OFF_MOD   = 0;
constexpr size_t OFF_CTR   = 36864;
constexpr size_t OFF_BAR   = 40960;
constexpr size_t OFF_WIN_T = 65536;
constexpr size_t OFF_WOUT_T= OFF_WIN_T + 3584ull*1024*2;
constexpr size_t OFF_WUQ_T = OFF_WOUT_T + 1024ull*1024*2;
constexpr size_t OFF_WUKV_T= OFF_WUQ_T + 768ull*384*2;
constexpr size_t OFF_WL_T  = OFF_WUKV_T + 1024ull*256*2;
constexpr size_t SMALL_END = 11ull*1048576;
constexpr size_t OFF_X1    = SMALL_END;
constexpr size_t OFF_USH   = OFF_X1;
constexpr size_t OFF_UMLA  = OFF_X1 + (size_t)T_ALL*1792*2;
constexpr size_t SZ_ARR    = (size_t)T_ALL*512*2;
constexpr size_t OFF_E     = OFF_X1;
constexpr size_t OFF_A     = OFF_X1 + 2*SZ_ARR;
constexpr size_t OFF_X2    = OFF_X1 + (size_t)T_ALL*(1792+672)*2;
constexpr size_t OFF_H     = OFF_X2;
constexpr size_t OFF_CQ    = OFF_X2;
constexpr size_t OFF_CKV   = OFF_CQ + (size_t)T_ALL*384*2;
constexpr size_t OFF_LW    = OFF_CKV + (size_t)T_ALL*256*2;
constexpr size_t OFF_MIX   = OFF_X2;
constexpr size_t OFF_X3    = OFF_X2 + (size_t)T_ALL*1024*2;
constexpr size_t OFF_R     = OFF_X3;
constexpr size_t OFF_K     = OFF_X3 + SZ_ARR;
constexpr size_t OFF_V     = OFF_X3 + 2*SZ_ARR;
constexpr size_t OFF_KK    = OFF_X3 + 3*SZ_ARR;
constexpr size_t OFF_KR    = OFF_X3 + 4*SZ_ARR;
constexpr size_t OFF_KN    = OFF_KR + 2ull*LK*32*2;
constexpr size_t OFF_VT    = OFF_KN + 2ull*8*LK*64*2;
constexpr size_t OFF_YB    = OFF_VT + 2ull*8*LK*64*2;
constexpr size_t WS_END    = OFF_YB + (size_t)T_LAT*512*2;
static_assert(WS_END <= 256ull*1048576, "workspace overflow");
constexpr size_t OOFF_G = 0;
constexpr size_t OOFF_Q = (size_t)T_LAT*1024*2;

struct Params {
  const float *x,*c,*ctx,*c_ctx,*ada_w,*ada_b,*norm_g,*w_in,*shift_mu,*rw_w0,*rw_w2,*rw_a0,*rw_a2,*rw_kk,*rw_ka,*rw_rk,
              *lnx_g,*lnx_b,*q_g,*kv_g,*w_uq,*w_ukv,*w_out,*final_g;
  float* out; unsigned char* ws;
  int ph_lo, ph_hi;
};

DI float bf2f(unsigned short b) { return __uint_as_float(((unsigned)b) << 16); }
typedef __bf16 hbf2 __attribute__((ext_vector_type(2)));
DI unsigned pack2(float a, float b) { f2 v = {a, b}; return __builtin_bit_cast(unsigned, __builtin_convertvector(v, hbf2)); }
DI unsigned short f2bf(float x) { return (unsigned short)(pack2(x, x) & 0xffffu); }
DI float lo16(unsigned u) { return __uint_as_float(u << 16); }
DI float hi16(unsigned u) { return __uint_as_float(u & 0xffff0000u); }
#define UNPACK8(v, f) do { f[0]=lo16(v.x); f[1]=hi16(v.x); f[2]=lo16(v.y); f[3]=hi16(v.y); f[4]=lo16(v.z); f[5]=hi16(v.z); f[6]=lo16(v.w); f[7]=hi16(v.w); } while (0)
#define PACK8(f) make_uint4(pack2(f[0],f[1]), pack2(f[2],f[3]), pack2(f[4],f[5]), pack2(f[6],f[7]))
DI float wave_sum(float v) { for (int o = 32; o > 0; o >>= 1) v += __shfl_xor(v, o); return v; }
DI float sum8(float v) { v += __shfl_xor(v, 1); v += __shfl_xor(v, 2); v += __shfl_xor(v, 4); return v; }
DI float siluf(float x) { return x / (1.f + __expf(-x)); }
DI float xhalf_max(float m) { const auto r = __builtin_amdgcn_permlane32_swap(__float_as_uint(m), __float_as_uint(m), false, false); return fmaxf(__uint_as_float(r[0]), __uint_as_float(r[1])); }
DI int crow(int i, int hh) { return (i & 3) + 8 * (i >> 2) + 4 * hh; }

constexpr int BM = 256, BN = 256, BK = 64, LDT = 72;
struct GemmDesc { const bf16_t* A; int lda; const bf16_t* Bt; int ldb; int K; };

template <class Epi>
DI void gemm_tile(const GemmDesc g, int m0, int n0, unsigned char* lds, Epi& epi) {
  int tid = threadIdx.x; asm volatile("" : "+v"(tid));
  const int lane = tid & 63, w = tid >> 6;
  constexpr int ASZ = BM * LDT, BSZ = BN * LDT;
  bf16_t* As = (bf16_t*)lds;
  bf16_t* Bs = As + 2 * ASZ;
  const int wm = w >> 2, wn = w & 3;
  f32x16 acc[4][2];
#pragma unroll
  for (int i = 0; i < 4; ++i)
#pragma unroll
    for (int j = 0; j < 2; ++j)
#pragma unroll
      for (int e = 0; e < 16; ++e) acc[i][j][e] = 0.f;
  uint4 ra0, ra1, ra2, ra3, rb0, rb1, rb2, rb3;
  const int nk = g.K / BK;
  const bf16_t* gA = g.A + (size_t)(m0 + (tid >> 3)) * g.lda + (tid & 7) * 8;
  const bf16_t* gB = g.Bt + (size_t)(n0 + (tid >> 3)) * g.ldb + (tid & 7) * 8;
  const size_t sA = (size_t)64 * g.lda, sB = (size_t)64 * g.ldb;
  bf16_t* lA = As + (tid >> 3) * LDT + (tid & 7) * 8;
  bf16_t* lB = Bs + (tid >> 3) * LDT + (tid & 7) * 8;
  const bf16_t* fA = As + (wm * 128 + (lane & 31)) * LDT + (lane >> 5) * 8;
  const bf16_t* fB = Bs + (wn * 64 + (lane & 31)) * LDT + (lane >> 5) * 8;
#define GLOAD(kt) do { const int ko = (kt) * BK; \
    ra0 = *(const uint4*)(gA + ko); ra1 = *(const uint4*)(gA + sA + ko); ra2 = *(const uint4*)(gA + 2 * sA + ko); ra3 = *(const uint4*)(gA + 3 * sA + ko); \
    rb0 = *(const uint4*)(gB + ko); rb1 = *(const uint4*)(gB + sB + ko); rb2 = *(const uint4*)(gB + 2 * sB + ko); rb3 = *(const uint4*)(gB + 3 * sB + ko); } while (0)
#define LSTORE(st) do { \
    *(uint4*)(lA + (st) * ASZ) = ra0; *(uint4*)(lA + (st) * ASZ + 64 * LDT) = ra1; *(uint4*)(lA + (st) * ASZ + 128 * LDT) = ra2; *(uint4*)(lA + (st) * ASZ + 192 * LDT) = ra3; \
    *(uint4*)(lB + (st) * BSZ) = rb0; *(uint4*)(lB + (st) * BSZ + 64 * LDT) = rb1; *(uint4*)(lB + (st) * BSZ + 128 * LDT) = rb2; *(uint4*)(lB + (st) * BSZ + 192 * LDT) = rb3; } while (0)
#define COMPUTE(st) do { \
    _Pragma("unroll") for (int kk = 0; kk < 4; ++kk) { \
      bf16x8 a[4], b[2]; \
      _Pragma("unroll") for (int i = 0; i < 4; ++i) a[i] = *(const bf16x8*)(fA + (st) * ASZ + i * 32 * LDT + kk * 16); \
      _Pragma("unroll") for (int j = 0; j < 2; ++j) b[j] = *(const bf16x8*)(fB + (st) * BSZ + j * 32 * LDT + kk * 16); \
      _Pragma("unroll") for (int i = 0; i < 4; ++i) \
        _Pragma("unroll") for (int j = 0; j < 2; ++j) acc[i][j] = __builtin_amdgcn_mfma_f32_32x32x16_bf16(a[i], b[j], acc[i][j], 0, 0, 0); } } while (0)
  __syncthreads();
  GLOAD(0);
  LSTORE(0);
  __syncthreads();
  for (int kt = 0; kt < nk; kt += 2) {
    const bool h1 = kt + 1 < nk, h2 = kt + 2 < nk;
    if (h1) GLOAD(kt + 1);
    COMPUTE(0);
    if (h1) LSTORE(1);
    __syncthreads();
    if (h1) {
      if (h2) GLOAD(kt + 2);
      COMPUTE(1);
      if (h2) LSTORE(0);
      __syncthreads();
    }
  }
#undef GLOAD
#undef LSTORE
#undef COMPUTE
#pragma unroll
  for (int i = 0; i < 4; ++i)
#pragma unroll
    for (int j = 0; j < 2; ++j) epi(m0 + wm * 128 + i * 32 + 4 * (lane >> 5), n0 + wn * 64 + j * 32 + (lane & 31), acc[i][j]);
}

struct EpiP1 { bf16_t *ush, *umla, *g;
  DI void operator()(int rb, int col, const f32x16& v) {
    if (col >= 3488) return;
    bf16_t* dst; int ld; bool lat_only = false;
    if (col < 1792) { dst = ush + col; ld = 1792; }
    else if (col < 2304) { dst = g + (col - 1792); ld = 1024; lat_only = true; }
    else if (col < 2976) { dst = umla + (col - 2304); ld = 672; }
    else { dst = g + 512 + (col - 2976); ld = 1024; lat_only = true; }
#pragma unroll
    for (int i = 0; i < 16; ++i) { int r = rb + (i & 3) + 8 * (i >> 2); if (!lat_only || r < T_LAT) dst[(size_t)r * ld] = f2bf(v[i]); }
  } };
struct EpiLora { bf16_t* dst; const float* bias; int isA;
  DI void operator()(int rb, int col, const f32x16& v) {
    const float bz = bias[col];
    const float sc = isA ? 1.f : 0.6065306597126334f;
#pragma unroll
    for (int i = 0; i < 16; ++i) { int r = rb + (i & 3) + 8 * (i >> 2);
      const float z = bz + v[i];
      const float o = sc * __builtin_amdgcn_rcpf(1.f + __expf(-z));
      dst[(size_t)r * 512 + col] = f2bf(o); }
  } };
struct EpiQ { bf16_t* q;
  DI void operator()(int rb, int col, const f32x16& v) {
    const int h = col / 96, dd = col - h * 96;
    const bool rope = dd >= 64;
    const int cc = dd - 64;
    const int fi = cc & 7; const bool second = (cc & 8) != 0; const bool colaxis = cc >= 16;
    const float invf = exp2f(-(float)fi * (13.287712379549449f / 8.f));
    const float sc = 0.10206207261596577f * 1.4426950408889634f;
#pragma unroll
    for (int i = 0; i < 16; ++i) { int r = rb + (i & 3) + 8 * (i >> 2);
      const int b = r >> 13, t = r & 8191;
      float x = v[i];
      if (rope) {
        float partner = __shfl_xor(x, 8);
        float pos = (float)(colaxis ? (t & 63) : (t >> 6));
        float ang = pos * invf; float cs = __cosf(ang), sn = __sinf(ang);
        x = second ? (partner * sn + x * cs) : (x * cs - partner * sn);
      }
      q[((size_t)(b * 8 + h) * SEQ + t) * 96 + dd] = f2bf(x * sc); }
  } };
struct EpiKV { bf16_t *kn, *vt;
  DI void operator()(int rb, int col, const f32x16& v) {
    const int h = col >> 7, dd = col & 127;
    if (dd < 64) {
#pragma unroll
      for (int i = 0; i < 16; ++i) { int r = rb + (i & 3) + 8 * (i >> 2);
        int b, pos; if (r < T_LAT) { b = r >> 13; pos = r & 8191; } else { b = (r - T_LAT) >> 8; pos = SEQ + ((r - T_LAT) & 255); }
        kn[((size_t)(b * 8 + h) * LK + pos) * 64 + dd] = f2bf(v[i]); }
    } else {
#pragma unroll
      for (int g = 0; g < 4; ++g) {
        const int r = rb + 8 * g;
        int b, pos; if (r < T_LAT) { b = r >> 13; pos = r & 8191; } else { b = (r - T_LAT) >> 8; pos = SEQ + ((r - T_LAT) & 255); }
        const int pp = (pos & ~12) | ((pos & 4) << 1) | ((pos & 8) >> 1);
        *(uint2*)(vt + ((size_t)(b * 8 + h) * 64 + (dd - 64)) * LK + pp) = make_uint2(pack2(v[4 * g], v[4 * g + 1]), pack2(v[4 * g + 2], v[4 * g + 3]));
      }
    }
  } };
struct EpiOut { const float* __restrict__ x; const float* __restrict__ mod; bf16_t* __restrict__ pre;
  DI void operator()(int rb, int col, const f32x16& v) {
    const float gt = mod[(rb >> 13) * 3072 + 2048 + col];
    float xv[16];
#pragma unroll
    for (int i = 0; i < 16; ++i) { const int r = rb + (i & 3) + 8 * (i >> 2); xv[i] = x[(size_t)r * 1024 + col]; }
#pragma unroll
    for (int i = 0; i < 16; ++i) { const int r = rb + (i & 3) + 8 * (i >> 2); pre[(size_t)r * 1024 + col] = f2bf(xv[i] + gt * v[i]); }
  } };

DI void transpose_tile(const float* src, int K, int N, bf16_t* dst, int kt, int nt, float* tile) {
  const int tid = threadIdx.x;
  __syncthreads();
#pragma unroll
  for (int i = 0; i < 8; ++i) { int kk = (tid >> 6) + i * 8, nn = tid & 63; int n = nt * 64 + nn;
    tile[kk * 65 + nn] = (n < N) ? src[(size_t)(kt * 64 + kk) * N + n] : 0.f; }
  __syncthreads();
#pragma unroll
  for (int i = 0; i < 8; ++i) { int nn = (tid >> 6) + i * 8, kk = tid & 63;
    dst[(size_t)(nt * 64 + nn) * K + kt * 64 + kk] = f2bf(tile[kk * 65 + nn]); }
}

DI void phase0(const Params& P, unsigned char* lds) {
  const int tid = threadIdx.x;
  float* fl = (float*)lds;
  const int n_mod = 192, n_win = 16 * 56, n_wout = 256, n_wuq = 72, n_wukv = 64, n_l = 32;
  const int total = n_mod + n_win + n_wout + n_wuq + n_wukv + n_l;
  for (int it = blockIdx.x; it < total; it += gridDim.x) {
    int r = it;
    if (r < n_mod) {
      __syncthreads();
      for (int i = tid; i < 3072; i += NTHR) { int sidx = i >> 10, k = i & 1023; float cv = (sidx == 0) ? P.c[k] : (sidx == 1) ? P.c[1024 + k] : P.c_ctx[k]; fl[i] = siluf(cv); }
      __syncthreads();
      const int cl = tid & 15, kg = tid >> 4, n0 = r * 16;
      float a0 = 0, a1 = 0, a2 = 0;
#pragma unroll 8
      for (int k = kg; k < 1024; k += 32) { float wv = P.ada_w[(size_t)k * 3072 + n0 + cl]; a0 += fl[k] * wv; a1 += fl[1024 + k] * wv; a2 += fl[2048 + k] * wv; }
      __syncthreads();
      fl[4096 + (kg * 3 + 0) * 16 + cl] = a0; fl[4096 + (kg * 3 + 1) * 16 + cl] = a1; fl[4096 + (kg * 3 + 2) * 16 + cl] = a2;
      __syncthreads();
      if (tid < 48) { int sidx = tid >> 4; float sum = 0; for (int qq = 0; qq < 32; ++qq) sum += fl[4096 + (qq * 3 + sidx) * 16 + cl];
        ((float*)(P.ws + OFF_MOD))[sidx * 3072 + n0 + cl] = sum + P.ada_b[n0 + cl]; }
      continue;
    }
    r -= n_mod;
    if (r < n_win) { transpose_tile(P.w_in, 1024, 3488, (bf16_t*)(P.ws + OFF_WIN_T), r / 56, r % 56, fl); continue; }
    r -= n_win;
    if (r < n_wout) { transpose_tile(P.w_out, 1024, 1024, (bf16_t*)(P.ws + OFF_WOUT_T), r / 16, r % 16, fl); continue; }
    r -= n_wout;
    if (r < n_wuq) { transpose_tile(P.w_uq, 384, 768, (bf16_t*)(P.ws + OFF_WUQ_T), r / 12, r % 12, fl); continue; }
    r -= n_wuq;
    if (r < n_wukv) { transpose_tile(P.w_ukv, 256, 1024, (bf16_t*)(P.ws + OFF_WUKV_T), r / 16, r % 16, fl); continue; }
    r -= n_wukv;
    { int g = r >> 3, nt = r & 7; const float* src = (g < 2) ? (P.rw_w2 + (size_t)g * 64 * 512) : (P.rw_a2 + (size_t)(g - 2) * 64 * 512);
      transpose_tile(src, 64, 512, (bf16_t*)(P.ws + OFF_WL_T) + (size_t)g * 512 * 64, 0, nt, fl); }
  }
}

struct Row4 { float4 a, b, c, d; };
DI void row_load(Row4& r, const float* src, int lane) {
  r.a = *(const float4*)(src + lane * 4); r.b = *(const float4*)(src + 256 + lane * 4);
  r.c = *(const float4*)(src + 512 + lane * 4); r.d = *(const float4*)(src + 768 + lane * 4);
}
DI void row_load_nt(Row4& r, const float* src, int lane) {
  typedef float nt4 __attribute__((ext_vector_type(4)));
  const nt4 a = __builtin_nontemporal_load((const nt4*)(src + lane * 4)), b = __builtin_nontemporal_load((const nt4*)(src + 256 + lane * 4));
  const nt4 c = __builtin_nontemporal_load((const nt4*)(src + 512 + lane * 4)), d = __builtin_nontemporal_load((const nt4*)(src + 768 + lane * 4));
  r.a = make_float4(a.x, a.y, a.z, a.w); r.b = make_float4(b.x, b.y, b.z, b.w); r.c = make_float4(c.x, c.y, c.z, c.w); r.d = make_float4(d.x, d.y, d.z, d.w);
}
DI float dot4(const float4& v) { return v.x * v.x + v.y * v.y + v.z * v.z + v.w * v.w; }
DI float row_rstd(const Row4& r) { return rsqrtf(wave_sum(dot4(r.a) + dot4(r.b) + dot4(r.c) + dot4(r.d)) * (1.f / 1024.f) + 1e-6f); }
DI void p1_store(const Params& P, const float* mod, bf16_t* H, int m, const Row4& r, int lane) {
  const int s = (m < T_LAT) ? (m >> 13) : 2;
  const float rstd = row_rstd(r);
  const float4 vv[4] = {r.a, r.b, r.c, r.d};
#pragma unroll
  for (int i = 0; i < 4; ++i) { const int c = i * 256 + lane * 4;
    const float4 g = *(const float4*)(P.norm_g + c), sh = *(const float4*)(mod + s * 3072 + c), sc = *(const float4*)(mod + s * 3072 + 1024 + c);
    const float4 v = vv[i];
    const float o0 = v.x * rstd * g.x * (1.f + sc.x) + sh.x, o1 = v.y * rstd * g.y * (1.f + sc.y) + sh.y;
    const float o2 = v.z * rstd * g.z * (1.f + sc.z) + sh.z, o3 = v.w * rstd * g.w * (1.f + sc.w) + sh.w;
    *(uint2*)(H + (size_t)m * 1024 + c) = make_uint2(pack2(o0, o1), pack2(o2, o3)); }
}
DI void phase1(const Params& P) {
  const int lane = threadIdx.x & 63, gw = blockIdx.x * 8 + (threadIdx.x >> 6), nw = gridDim.x * 8;
  const float* mod = (const float*)(P.ws + OFF_MOD);
  bf16_t* H = (bf16_t*)(P.ws + OFF_H);
#define P1SRC(m) (((m) < T_LAT) ? (P.x + (size_t)(m) * 1024) : (P.ctx + (size_t)((m) - T_LAT) * 1024))
  for (int m = gw; m < T_ALL; m += 4 * nw) {
    const int m1 = m + nw, m2 = m + 2 * nw, m3 = m + 3 * nw;
    Row4 r0, r1, r2, r3;
    row_load_nt(r0, P1SRC(m), lane);
    if (m1 < T_ALL) row_load_nt(r1, P1SRC(m1), lane);
    if (m2 < T_ALL) row_load_nt(r2, P1SRC(m2), lane);
    if (m3 < T_ALL) row_load_nt(r3, P1SRC(m3), lane);
    p1_store(P, mod, H, m, r0, lane);
    if (m1 < T_ALL) p1_store(P, mod, H, m1, r1, lane);
    if (m2 < T_ALL) p1_store(P, mod, H, m2, r2, lane);
    if (m3 < T_ALL) p1_store(P, mod, H, m3, r3, lane);
  }
#undef P1SRC
}

DI void phase2(const Params& P, unsigned char* lds) {
  GemmDesc g{(const bf16_t*)(P.ws + OFF_H), 1024, (const bf16_t*)(P.ws + OFF_WIN_T), 1024, 1024};
  EpiP1 e{(bf16_t*)(P.ws + OFF_USH), (bf16_t*)(P.ws + OFF_UMLA), (bf16_t*)((unsigned char*)P.out + OOFF_G)};
  for (int t = blockIdx.x; t < 66 * 14; t += gridDim.x) gemm_tile(g, (t / 14) * BM, (t % 14) * BN, lds, e);
}

DI void phase3(const Params& P) {
  const int lane = threadIdx.x & 63, gw = blockIdx.x * 8 + (threadIdx.x >> 6), nw = gridDim.x * 8;
  const bf16_t* __restrict__ USH = (const bf16_t*)(P.ws + OFF_USH);
  const bf16_t* __restrict__ UMLA = (const bf16_t*)(P.ws + OFF_UMLA);
  for (int m = gw; m < T_ALL; m += nw) {
    int b, t, len, kpos;
    if (m < T_LAT) { b = m >> 13; t = m & 8191; len = SEQ; kpos = t; } else { b = (m - T_LAT) >> 8; t = (m - T_LAT) & 255; len = CTXL; kpos = SEQ + t; }
    const bool hasp = t > 0, hasn = t < len - 1;
    const uint4 z4 = make_uint4(0, 0, 0, 0);
#pragma unroll
    for (int arr = 0; arr < 3; ++arr) {
      const int col = arr * 512 + lane * 8;
      uint4 cu = *(const uint4*)(USH + (size_t)m * 1792 + col);
      uint4 pu = hasp ? *(const uint4*)(USH + (size_t)(m - 1) * 1792 + col) : z4;
      uint4 nu = hasn ? *(const uint4*)(USH + (size_t)(m + 1) * 1792 + col) : z4;
      float c8[8], p8[8], n8[8], o8[8]; UNPACK8(cu, c8); UNPACK8(pu, p8); UNPACK8(nu, n8);
#pragma unroll
      for (int j = 0; j < 8; ++j) { float mu0 = P.shift_mu[col + j], mu1 = P.shift_mu[1792 + col + j]; o8[j] = c8[j] + mu0 * (p8[j] - c8[j]) + mu1 * (n8[j] - c8[j]); }
      bf16_t* dst = (bf16_t*)(P.ws + OFF_R + arr * SZ_ARR) + (size_t)m * 512 + lane * 8;
      *(uint4*)dst = PACK8(o8);
      if (arr == 1) {
        float k8[8], ss = 0;
#pragma unroll
        for (int j = 0; j < 8; ++j) { k8[j] = o8[j] * P.rw_kk[lane * 8 + j]; ss += k8[j] * k8[j]; }
        ss = sum8(ss);
        const float inv = rsqrtf(fmaxf(ss, 1e-24f));
#pragma unroll
        for (int j = 0; j < 8; ++j) k8[j] *= inv;
        *(uint4*)((bf16_t*)(P.ws + OFF_KK) + (size_t)m * 512 + lane * 8) = PACK8(k8);
      }
    }
    {
      const int col = 1536 + lane * 4;
      uint2 cu = *(const uint2*)(USH + (size_t)m * 1792 + col);
      uint2 pu = hasp ? *(const uint2*)(USH + (size_t)(m - 1) * 1792 + col) : make_uint2(0, 0);
      uint2 nu = hasn ? *(const uint2*)(USH + (size_t)(m + 1) * 1792 + col) : make_uint2(0, 0);
      float c4[4] = {lo16(cu.x), hi16(cu.x), lo16(cu.y), hi16(cu.y)}, p4[4] = {lo16(pu.x), hi16(pu.x), lo16(pu.y), hi16(pu.y)}, n4[4] = {lo16(nu.x), hi16(nu.x), lo16(nu.y), hi16(nu.y)}, o4[4];
#pragma unroll
      for (int j = 0; j < 4; ++j) { float mu0 = P.shift_mu[col + j], mu1 = P.shift_mu[1792 + col + j]; float o = c4[j] + mu0 * (p4[j] - c4[j]) + mu1 * (n4[j] - c4[j]);
        if (lane < 32) { float e2 = __expf(2.f * o); o = 1.f - 2.f / (e2 + 1.f); }
        o4[j] = o; }
      *(uint2*)((bf16_t*)(P.ws + OFF_LW) + (size_t)m * 256 + lane * 4) = make_uint2(pack2(o4[0], o4[1]), pack2(o4[2], o4[3]));
    }
    {
      float x8[8]; float ss = 0;
      if (lane < 48) { uint4 u = *(const uint4*)(UMLA + (size_t)m * 672 + lane * 8); UNPACK8(u, x8);
#pragma unroll
        for (int j = 0; j < 8; ++j) ss += x8[j] * x8[j]; }
      ss = wave_sum(ss);
      const float rstd = rsqrtf(ss * (1.f / 384.f) + 1e-6f);
      if (lane < 48) {
#pragma unroll
        for (int j = 0; j < 8; ++j) x8[j] = x8[j] * rstd * P.q_g[lane * 8 + j];
        *(uint4*)((bf16_t*)(P.ws + OFF_CQ) + (size_t)m * 384 + lane * 8) = PACK8(x8); }
    }
    {
      float x8[8]; float ss = 0;
      if (lane < 32) { uint4 u = *(const uint4*)(UMLA + (size_t)m * 672 + 384 + lane * 8); UNPACK8(u, x8);
#pragma unroll
        for (int j = 0; j < 8; ++j) ss += x8[j] * x8[j]; }
      ss = wave_sum(ss);
      const float rstd = rsqrtf(ss * (1.f / 256.f) + 1e-6f);
      if (lane < 32) {
#pragma unroll
        for (int j = 0; j < 8; ++j) x8[j] = x8[j] * rstd * P.kv_g[lane * 8 + j];
        *(uint4*)((bf16_t*)(P.ws + OFF_CKV) + (size_t)m * 256 + lane * 8) = PACK8(x8); }
    }
    {
      float x8[8];
      const int l4 = lane & 3;
      uint4 u = *(const uint4*)(UMLA + (size_t)m * 672 + 640 + l4 * 8); UNPACK8(u, x8);
      const bool lat = m < T_LAT;
      const float pos = (float)((l4 < 2) ? (t >> 6) : (t & 63));
#pragma unroll
      for (int j = 0; j < 8; ++j) {
        float partner = __shfl_xor(x8[j], 1);
        if (lat) { float ang = pos * exp2f(-(float)j * (13.287712379549449f / 8.f)); float cs = __cosf(ang), sn = __sinf(ang);
          x8[j] = (l4 & 1) ? (partner * sn + x8[j] * cs) : (x8[j] * cs - partner * sn); }
      }
      if (lane < 4) *(uint4*)((bf16_t*)(P.ws + OFF_KR) + ((size_t)b * LK + kpos) * 32 + lane * 8) = PACK8(x8);
    }
  }
}

DI void phase4(const Params& P, unsigned char* lds) {
  const int nl = 4 * 66 * 2, nq = 64 * 3, nkv = 66 * 4;
  for (int it = blockIdx.x; it < nl + nq + nkv; it += gridDim.x) {
    int r = it;
    if (r < nl) { const int g = r / 132, rr = r % 132, tm = rr >> 1, tn = rr & 1; const int d = g & 1, isA = g >> 1;
      GemmDesc gd{(const bf16_t*)(P.ws + OFF_LW) + g * 64, 256, (const bf16_t*)(P.ws + OFF_WL_T) + (size_t)g * 512 * 64, 64, 64};
      EpiLora e{(bf16_t*)(P.ws + (isA ? OFF_A : OFF_E) + d * SZ_ARR), (isA ? P.rw_a0 : P.rw_w0) + d * 512, isA};
      gemm_tile(gd, tm * BM, tn * BN, lds, e); continue; }
    r -= nl;
    if (r < nq) { GemmDesc gd{(const bf16_t*)(P.ws + OFF_CQ), 384, (const bf16_t*)(P.ws + OFF_WUQ_T), 384, 384};
      EpiQ e{(bf16_t*)((unsigned char*)P.out + OOFF_Q)};
      gemm_tile(gd, (r / 3) * BM, (r % 3) * BN, lds, e); continue; }
    r -= nq;
    { GemmDesc gd{(const bf16_t*)(P.ws + OFF_CKV), 256, (const bf16_t*)(P.ws + OFF_WUKV_T), 256, 256};
      EpiKV e{(bf16_t*)(P.ws + OFF_KN), (bf16_t*)(P.ws + OFF_VT)};
      gemm_tile(gd, (r >> 2) * BM, (r & 3) * BN, lds, e); }
  }
}

constexpr int CH = 32, SREC = 352;
constexpr int SCAN_IN_FLOATS = 2 * CH * SREC, SCAN_Y_FLOATS = 2 * CH * 32;
constexpr int LDS_BYTES = 2 * (256 + 256) * 72 * 2 + 256;
static_assert(LDS_BYTES >= (SCAN_IN_FLOATS + SCAN_Y_FLOATS + 2 * 16 * CH) * 4 + 256, "lds scan");
template <int CTRL> DI float dppf(float v) { return __int_as_float(__builtin_amdgcn_update_dpp(0, __float_as_int(v), CTRL, 0xf, 0xf, false)); }
DI float red8(float p) { p += dppf<0xB1>(p); p += dppf<0x4E>(p); p += dppf<0x141>(p); return p; }
DI float red16(float p) { p += dppf<0xB1>(p); p += dppf<0x4E>(p); p += dppf<0x141>(p); p += dppf<0x140>(p); return p; }
struct StepOps { float4 a, b, w, k, r; };
DI void ld_ops(StepOps& o, const float* rec, int q4) {
  o.a = *(const float4*)(rec + q4);
  o.b = *(const float4*)(rec + 64 + q4);
  o.w = *(const float4*)(rec + 128 + q4);
  o.k = *(const float4*)(rec + 192 + q4);
  o.r = *(const float4*)(rec + 256 + q4);
}

DI void scan_task(const Params& P, int sb, unsigned char* lds) {
  const int qtr = sb & 3, h = (sb >> 2) & 7, b = (sb >> 5) & 1, d = sb >> 6;
  const int tid = threadIdx.x, lane = tid & 63, w = __builtin_amdgcn_readfirstlane(tid >> 6);
  float* buf = (float*)lds;
  float* ybuf = buf + SCAN_IN_FLOATS;
  float* vtb = ybuf + SCAN_Y_FLOATS;
  const bf16_t* R = (const bf16_t*)(P.ws + OFF_R); const bf16_t* K = (const bf16_t*)(P.ws + OFF_K);
  const bf16_t* V = (const bf16_t*)(P.ws + OFF_V); const bf16_t* KKp = (const bf16_t*)(P.ws + OFF_KK);
  const bf16_t* Ad = (const bf16_t*)(P.ws + OFF_A + d * SZ_ARR); const bf16_t* Ed = (const bf16_t*)(P.ws + OFF_E + d * SZ_ARR);
  bf16_t* Yf = (bf16_t*)(P.ws + OFF_MIX); bf16_t* Yb = (bf16_t*)(P.ws + OFF_YB);
  const int NCH = LK / CH;
  __syncthreads();
  if (w >= 4) {
    const int lt = tid - 256, tok = lt >> 3, cgp = lt & 7, col = h * 64 + cgp * 8;
    float ka[8];
#pragma unroll
    for (int j = 0; j < 8; ++j) ka[j] = P.rw_ka[col + j];
    uint4 urA, ukA, ukkA, uaA, ueA, uvA = make_uint4(0, 0, 0, 0), urB, ukB, ukkB, uaB, ueB, uvB = make_uint4(0, 0, 0, 0);
#define RAWLOAD(cc, X) do { \
      const int s_ = (cc) * CH + tok; int m_; \
      if (s_ < CTXL) { int tc = d ? (CTXL - 1 - s_) : s_; m_ = T_LAT + b * CTXL + tc; } else { int u_ = s_ - CTXL; int t_ = d ? (SEQ - 1 - u_) : u_; m_ = b * SEQ + t_; } \
      const size_t off = (size_t)m_ * 512 + col; \
      ur##X = *(const uint4*)(R + off); uk##X = *(const uint4*)(K + off); ukk##X = *(const uint4*)(KKp + off); ua##X = *(const uint4*)(Ad + off); ue##X = *(const uint4*)(Ed + off); \
      if (cgp < 2) uv##X = *(const uint4*)(V + (size_t)m_ * 512 + h * 64 + qtr * 16 + cgp * 8); } while (0)
#define CONVSTORE(cc, X) do { \
      float r8[8], k8[8], kk8[8], a8[8], e8[8], v8[8]; UNPACK8(ur##X, r8); UNPACK8(uk##X, k8); UNPACK8(ukk##X, kk8); UNPACK8(ua##X, a8); UNPACK8(ue##X, e8); UNPACK8(uv##X, v8); \
      float* dst = buf + ((cc) & 1) * (CH * SREC) + tok * SREC; \
      float na[8], bd[8], wd[8], kd[8]; \
      _Pragma("unroll") for (int j = 0; j < 8; ++j) { na[j] = -kk8[j]; bd[j] = kk8[j] * a8[j]; wd[j] = __expf(-e8[j]); kd[j] = k8[j] * (1.f + (a8[j] - 1.f) * ka[j]); } \
      *(float4*)(dst + cgp * 8) = make_float4(na[0], na[1], na[2], na[3]); *(float4*)(dst + cgp * 8 + 4) = make_float4(na[4], na[5], na[6], na[7]); \
      *(float4*)(dst + 64 + cgp * 8) = make_float4(bd[0], bd[1], bd[2], bd[3]); *(float4*)(dst + 64 + cgp * 8 + 4) = make_float4(bd[4], bd[5], bd[6], bd[7]); \
      *(float4*)(dst + 128 + cgp * 8) = make_float4(wd[0], wd[1], wd[2], wd[3]); *(float4*)(dst + 128 + cgp * 8 + 4) = make_float4(wd[4], wd[5], wd[6], wd[7]); \
      *(float4*)(dst + 192 + cgp * 8) = make_float4(kd[0], kd[1], kd[2], kd[3]); *(float4*)(dst + 192 + cgp * 8 + 4) = make_float4(kd[4], kd[5], kd[6], kd[7]); \
      *(float4*)(dst + 256 + cgp * 8) = make_float4(r8[0], r8[1], r8[2], r8[3]); *(float4*)(dst + 256 + cgp * 8 + 4) = make_float4(r8[4], r8[5], r8[6], r8[7]); \
      if (cgp < 2) { float* vt_ = vtb + ((cc) & 1) * (16 * CH) + (cgp * 8) * CH + tok; \
        _Pragma("unroll") for (int j = 0; j < 8; ++j) vt_[j * CH] = v8[j]; } \
    } while (0)
#define YFLUSH(cc) do { \
      const int u_ = (cc) * CH + tok - CTXL; const int t_ = d ? (SEQ - 1 - u_) : u_; \
      const float2 yv = *(const float2*)(ybuf + ((cc) & 1) * (CH * 16) + tok * 16 + cgp * 2); \
      const size_t mrow = (size_t)b * SEQ + t_; const int cc_ = h * 64 + qtr * 16 + cgp * 2; \
      if (d == 0) *(unsigned*)(Yf + mrow * 1024 + cc_) = pack2(yv.x, yv.y); else *(unsigned*)(Yb + mrow * 512 + cc_) = pack2(yv.x, yv.y); } while (0)
    RAWLOAD(0, A); CONVSTORE(0, A); RAWLOAD(1, A); RAWLOAD(2, B);
    __syncthreads();
    for (int c = 0; c < NCH; c += 2) {
      if (c + 1 < NCH) CONVSTORE(c + 1, A);
      if (c + 3 < NCH) RAWLOAD(c + 3, A);
      if (c - 1 >= CTXL / CH) YFLUSH(c - 1);
      __syncthreads();
      if (c + 2 < NCH) CONVSTORE(c + 2, B);
      if (c + 4 < NCH) RAWLOAD(c + 4, B);
      if (c >= CTXL / CH) YFLUSH(c);
      __syncthreads();
    }
    YFLUSH(NCH - 1);
#undef RAWLOAD
#undef CONVSTORE
#undef YFLUSH
  } else {
    const int q = lane & 15, q4 = q * 4, rowl = w * 4 + (lane >> 4);
    const bool o1 = (lane & 1) != 0, o2 = (lane & 2) != 0;
    f2 S0 = {0.f, 0.f}, S1 = {0.f, 0.f};
    __syncthreads();
    for (int c = 0; c < NCH; ++c) {
      const float* cb = buf + (c & 1) * (CH * SREC);
      const float* vrow = vtb + (c & 1) * (16 * CH) + rowl * CH;
      float* yb = ybuf + (c & 1) * (CH * 16);
      StepOps cur, nxt, nx2, nx3;
      ld_ops(cur, cb, q4);
      ld_ops(nxt, cb + SREC, q4);
      ld_ops(nx2, cb + 2 * SREC, q4);
#pragma unroll 1
      for (int g4 = 0; g4 < CH / 4; ++g4) {
        const float* gb = cb + g4 * 4 * SREC;
        const float4 v4 = *(const float4*)(vrow + g4 * 4);
        float pp[4];
#pragma unroll
        for (int i = 0; i < 4; ++i) {
          ld_ops(nx3, gb + (i + 3) * SREC, q4);
          const f2 a01 = {cur.a.x, cur.a.y}, a23 = {cur.a.z, cur.a.w}, w01 = {cur.w.x, cur.w.y}, w23 = {cur.w.z, cur.w.w};
          const f2 k01 = {cur.k.x, cur.k.y}, k23 = {cur.k.z, cur.k.w}, b01 = {cur.b.x, cur.b.y}, b23 = {cur.b.z, cur.b.w};
          const f2 r01 = {cur.r.x, cur.r.y}, r23 = {cur.r.z, cur.r.w};
          f2 pa = S0 * a01; pa += S1 * a23;
          const float vs = (i == 0) ? v4.x : (i == 1) ? v4.y : (i == 2) ? v4.z : v4.w;
          const f2 vv = {vs, vs};
          const f2 t0 = S0 * w01 + vv * k01, t1 = S1 * w23 + vv * k23;
          const float sa = red16(pa.x + pa.y);
          const f2 sa2 = {sa, sa};
          S0 = t0 + sa2 * b01; S1 = t1 + sa2 * b23;
          f2 py = S0 * r01; py += S1 * r23;
          pp[i] = py.x + py.y;
          cur = nxt; nxt = nx2; nx2 = nx3;
        }
        const float tA = o1 ? pp[0] : pp[1], kA = o1 ? pp[1] : pp[0];
        const float tB = o1 ? pp[2] : pp[3], kB = o1 ? pp[3] : pp[2];
        const float r0 = kA + dppf<0xB1>(tA), r1 = kB + dppf<0xB1>(tB);
        const float tC = o2 ? r0 : r1, kC = o2 ? r1 : r0;
        float u = kC + dppf<0x4E>(tC);
        u += dppf<0x124>(u);
        u += dppf<0x128>(u);
        yb[(g4 * 4 + (q & 3)) * 16 + rowl] = u;
      }
      __syncthreads();
    }
  }
}

constexpr int AK_LD = 104, AV_LD = 72, ABUF = 64 * AK_LD * 2 + 64 * AV_LD * 2;
DI void attn_item(const Params& P, int item, unsigned char* lds) {
  const int qb = item & 15, h = (item >> 4) & 7, b = item >> 7;
  int tid = threadIdx.x; asm volatile("" : "+v"(tid));
  const int lane = tid & 63, w = tid >> 6, l31 = lane & 31, hh = lane >> 5;
  const bf16_t* Q = (const bf16_t*)((const unsigned char*)P.out + OOFF_Q) + ((size_t)(b * 8 + h) * SEQ + qb * 512 + w * 64) * 96;
  const bf16_t* KN = (const bf16_t*)(P.ws + OFF_KN) + (size_t)(b * 8 + h) * LK * 64;
  const bf16_t* KR = (const bf16_t*)(P.ws + OFF_KR) + (size_t)b * LK * 32;
  const bf16_t* VT = (const bf16_t*)(P.ws + OFF_VT) + (size_t)(b * 8 + h) * 64 * LK;
  bf16x8 qa0, qa1, qa2, qa3, qa4, qa5, qb0, qb1, qb2, qb3, qb4, qb5;
  { const bf16_t* q0 = Q + (size_t)l31 * 96 + hh * 8; const bf16_t* q1 = q0 + 32 * 96;
    qa0 = *(const bf16x8*)(q0); qa1 = *(const bf16x8*)(q0 + 16); qa2 = *(const bf16x8*)(q0 + 32); qa3 = *(const bf16x8*)(q0 + 48); qa4 = *(const bf16x8*)(q0 + 64); qa5 = *(const bf16x8*)(q0 + 80);
    qb0 = *(const bf16x8*)(q1); qb1 = *(const bf16x8*)(q1 + 16); qb2 = *(const bf16x8*)(q1 + 32); qb3 = *(const bf16x8*)(q1 + 48); qb4 = *(const bf16x8*)(q1 + 64); qb5 = *(const bf16x8*)(q1 + 80); }
  f32x16 O00, O01, O10, O11;
#pragma unroll
  for (int e = 0; e < 16; ++e) { O00[e] = 0.f; O01[e] = 0.f; O10[e] = 0.f; O11[e] = 0.f; }
  float m0 = -1e30f, l0 = 0.f, m1 = -1e30f, l1 = 0.f;
  constexpr int KB = 64 * AK_LD, VB = 64 * AV_LD;
  bf16_t* Kl = (bf16_t*)lds; bf16_t* Vl = Kl + 2 * KB;
  uint4 rk, rr = make_uint4(0, 0, 0, 0), rv;
#define TLOAD(kt) do { const int key0 = (kt) * 64; \
    rk = *(const uint4*)(KN + (size_t)(key0 + (tid >> 3)) * 64 + (tid & 7) * 8); \
    if (tid < 256) rr = *(const uint4*)(KR + (size_t)(key0 + (tid >> 2)) * 32 + (tid & 3) * 8); \
    rv = *(const uint4*)(VT + (size_t)(tid >> 3) * LK + key0 + (tid & 7) * 8); } while (0)
#define TSTORE(st) do { bf16_t* Ks = Kl + (st) * KB; \
    *(uint4*)(Ks + (tid >> 3) * AK_LD + (tid & 7) * 8) = rk; \
    if (tid < 256) *(uint4*)(Ks + (tid >> 2) * AK_LD + 64 + (tid & 3) * 8) = rr; \
    *(uint4*)(Vl + (st) * VB + (tid >> 3) * AV_LD + (tid & 7) * 8) = rv; } while (0)
#define MF(a, b, c) __builtin_amdgcn_mfma_f32_32x32x16_bf16((a), (b), (c), 0, 0, 0)
#define SOFTMAX(sa, sb, m, l, Oa, Ob) do { \
    float mloc = sa[0]; \
    _Pragma("unroll") for (int e = 1; e < 16; ++e) mloc = fmaxf(mloc, sa[e]); \
    _Pragma("unroll") for (int e = 0; e < 16; ++e) mloc = fmaxf(mloc, sb[e]); \
    mloc = xhalf_max(mloc); \
    if (__builtin_amdgcn_ballot_w64(mloc > m) != 0ull) { \
      const float mnew = fmaxf(m, mloc); const float alpha = __builtin_amdgcn_exp2f(m - mnew); \
      m = mnew; l *= alpha; \
      _Pragma("unroll") for (int e = 0; e < 16; ++e) { Oa[e] *= alpha; Ob[e] *= alpha; } } \
    float pa = 0.f, pb = 0.f; \
    _Pragma("unroll") for (int e = 0; e < 16; ++e) { sa[e] = __builtin_amdgcn_exp2f(sa[e] - m); pa += sa[e]; sb[e] = __builtin_amdgcn_exp2f(sb[e] - m); pb += sb[e]; } \
    l += pa + pb; } while (0)
#define PK8(sv, o) make_uint4(pack2(sv[(o) + 0], sv[(o) + 1]), pack2(sv[(o) + 2], sv[(o) + 3]), pack2(sv[(o) + 4], sv[(o) + 5]), pack2(sv[(o) + 6], sv[(o) + 7]))
  const int NKT = LK / 64;
  __syncthreads();
  TLOAD(0); TSTORE(0);
  __syncthreads();
  for (int kt = 0; kt < NKT; ++kt) {
    { const int k1 = (kt + 1 < NKT) ? kt + 1 : NKT - 1; TLOAD(k1); }
    const bf16_t* Ks = Kl + (kt & 1) * KB; const bf16_t* Vs = Vl + (kt & 1) * VB;
    f32x16 s00, s01, s10, s11;
#pragma unroll
    for (int e = 0; e < 16; ++e) { s00[e] = 0.f; s01[e] = 0.f; s10[e] = 0.f; s11[e] = 0.f; }
    const bf16_t* kp = Ks + l31 * AK_LD + hh * 8;
#define QKSTEP(off, qa, qbb) do { const bf16x8 a0 = *(const bf16x8*)(kp + (off)), a1 = *(const bf16x8*)(kp + 32 * AK_LD + (off)); \
      s00 = MF(a0, qa, s00); s01 = MF(a1, qa, s01); s10 = MF(a0, qbb, s10); s11 = MF(a1, qbb, s11); } while (0)
    QKSTEP(0, qa0, qb0); QKSTEP(16, qa1, qb1); QKSTEP(32, qa2, qb2); QKSTEP(48, qa3, qb3); QKSTEP(64, qa4, qb4); QKSTEP(80, qa5, qb5);
#undef QKSTEP
    SOFTMAX(s00, s01, m0, l0, O00, O01);
    SOFTMAX(s10, s11, m1, l1, O10, O11);
    const bf16_t* vp = Vs + l31 * AV_LD + 8 * hh;
#define PVSTEP(sx, sy, o, koff) do { union { uint4 u; bf16x8 v; } p0, p1; p0.u = PK8(sx, o); p1.u = PK8(sy, o); \
      const bf16x8 v0 = *(const bf16x8*)(vp + (koff)), v1 = *(const bf16x8*)(vp + 32 * AV_LD + (koff)); \
      O00 = MF(v0, p0.v, O00); O01 = MF(v1, p0.v, O01); O10 = MF(v0, p1.v, O10); O11 = MF(v1, p1.v, O11); } while (0)
    PVSTEP(s00, s10, 0, 0); PVSTEP(s00, s10, 8, 16); PVSTEP(s01, s11, 0, 32); PVSTEP(s01, s11, 8, 48);
#undef PVSTEP
    TSTORE((kt + 1) & 1);
    __syncthreads();
  }
#undef TLOAD
#undef TSTORE
#undef SOFTMAX
#undef PK8
  const bf16_t* __restrict__ G = (const bf16_t*)((const unsigned char*)P.out + OOFF_G);
  bf16_t* __restrict__ MIX = (bf16_t*)(P.ws + OFF_MIX);
  int l31e = l31; asm volatile("" : "+v"(l31e));
#define AEPI(Oa, Ob, l, qt) do { \
    const float inv = 1.f / (l + __shfl_xor(l, 32)); \
    const int t = qb * 512 + w * 64 + (qt) * 32 + l31e; \
    const size_t rowoff = ((size_t)b * SEQ + t) * 1024 + 512 + h * 64; \
    _Pragma("unroll") for (int g4 = 0; g4 < 4; ++g4) { \
      const int dv = 8 * g4 + 4 * hh; \
      const uint2 ga = *(const uint2*)(G + rowoff + dv), gb = *(const uint2*)(G + rowoff + 32 + dv); \
      *(uint2*)(MIX + rowoff + dv) = make_uint2(pack2(Oa[4 * g4 + 0] * inv * siluf(lo16(ga.x)), Oa[4 * g4 + 1] * inv * siluf(hi16(ga.x))), \
                                                pack2(Oa[4 * g4 + 2] * inv * siluf(lo16(ga.y)), Oa[4 * g4 + 3] * inv * siluf(hi16(ga.y)))); \
      *(uint2*)(MIX + rowoff + 32 + dv) = make_uint2(pack2(Ob[4 * g4 + 0] * inv * siluf(lo16(gb.x)), Ob[4 * g4 + 1] * inv * siluf(hi16(gb.x))), \
                                                     pack2(Ob[4 * g4 + 2] * inv * siluf(lo16(gb.y)), Ob[4 * g4 + 3] * inv * siluf(hi16(gb.y)))); } } while (0)
  AEPI(O00, O01, l0, 0);
  AEPI(O10, O11, l1, 1);
#undef AEPI
#undef MF
}

DI void phase5(const Params& P, unsigned char* lds, int ctr_idx = 0) {
  int* sh_item = (int*)(lds + LDS_BYTES - 64);
  const int bx = (int)blockIdx.x;
  if ((int)gridDim.x == 2 * NSCAN) { if ((bx & 4) != 0) scan_task(P, (bx & 3) * 32 + (bx >> 3), lds); }
  else if (bx < NSCAN && (int)gridDim.x > NSCAN) scan_task(P, bx, lds);
  else if ((int)gridDim.x <= NSCAN) { for (int sb = bx; sb < NSCAN; sb += gridDim.x) scan_task(P, sb, lds); }
  int* ctr = (int*)(P.ws + OFF_CTR) + ctr_idx;
  for (;;) {
    __syncthreads();
    if (threadIdx.x == 0) *sh_item = atomicAdd(ctr, 1);
    __syncthreads();
    const int item = *sh_item;
    if (item >= 256) break;
    attn_item(P, item, lds);
  }
}

DI void phase6(const Params& P) {
  const int lane = threadIdx.x & 63, gw = blockIdx.x * 8 + (threadIdx.x >> 6), nw = gridDim.x * 8;
  bf16_t* MIX = (bf16_t*)(P.ws + OFF_MIX);
  const bf16_t* YB = (const bf16_t*)(P.ws + OFF_YB);
  const bf16_t* G = (const bf16_t*)((const unsigned char*)P.out + OOFF_G);
  const int c0 = lane * 8;
  for (int m = gw; m < T_LAT; m += nw) {
    float yf[8], yb[8], y[8], r8[8], k8[8], v8[8], a0[8], a1[8], g8[8], o8[8];
    uint4 u;
    u = *(const uint4*)(MIX + (size_t)m * 1024 + c0); UNPACK8(u, yf);
    u = *(const uint4*)(YB + (size_t)m * 512 + c0); UNPACK8(u, yb);
    u = *(const uint4*)((const bf16_t*)(P.ws + OFF_R) + (size_t)m * 512 + c0); UNPACK8(u, r8);
    u = *(const uint4*)((const bf16_t*)(P.ws + OFF_K) + (size_t)m * 512 + c0); UNPACK8(u, k8);
    u = *(const uint4*)((const bf16_t*)(P.ws + OFF_V) + (size_t)m * 512 + c0); UNPACK8(u, v8);
    u = *(const uint4*)((const bf16_t*)(P.ws + OFF_A) + (size_t)m * 512 + c0); UNPACK8(u, a0);
    u = *(const uint4*)((const bf16_t*)(P.ws + OFF_A + SZ_ARR) + (size_t)m * 512 + c0); UNPACK8(u, a1);
    u = *(const uint4*)(G + (size_t)m * 1024 + c0); UNPACK8(u, g8);
    float sm = 0, bon = 0;
#pragma unroll
    for (int j = 0; j < 8; ++j) { y[j] = yf[j] + yb[j]; sm += y[j];
      const float ka = P.rw_ka[c0 + j];
      const float kds = k8[j] * (2.f + (a0[j] + a1[j] - 2.f) * ka);
      bon += r8[j] * kds * P.rw_rk[c0 + j]; }
    sm = sum8(sm); bon = sum8(bon);
    const float mean = sm * (1.f / 64.f);
    float vs = 0;
#pragma unroll
    for (int j = 0; j < 8; ++j) { float dlt = y[j] - mean; vs += dlt * dlt; }
    vs = sum8(vs);
    const float rstd = rsqrtf(vs * (1.f / 64.f) + 64e-5f);
#pragma unroll
    for (int j = 0; j < 8; ++j) { float yn = (y[j] - mean) * rstd * P.lnx_g[c0 + j] + P.lnx_b[c0 + j]; o8[j] = (yn + bon * v8[j]) * siluf(g8[j]); }
    *(uint4*)(MIX + (size_t)m * 1024 + c0) = PACK8(o8);
  }
}

DI void phase7(const Params& P, unsigned char* lds) {
  GemmDesc g{(const bf16_t*)(P.ws + OFF_MIX), 1024, (const bf16_t*)(P.ws + OFF_WOUT_T), 1024, 1024};
  EpiOut e{P.x, (const float*)(P.ws + OFF_MOD), (bf16_t*)(P.ws + OFF_X1)};
  for (int t = blockIdx.x; t < 64 * 4; t += gridDim.x) gemm_tile(g, (t >> 2) * BM, (t & 3) * BN, lds, e);
}

DI void p8_store(const Params& P, float* row, const Row4& r, int lane) {
  const float rstd = row_rstd(r);
  const float4 vv[4] = {r.a, r.b, r.c, r.d};
#pragma unroll
  for (int i = 0; i < 4; ++i) { const int c = i * 256 + lane * 4; const float4 g = *(const float4*)(P.final_g + c); const float4 v = vv[i];
    typedef float nt4 __attribute__((ext_vector_type(4)));
    nt4 o = {v.x * rstd * g.x, v.y * rstd * g.y, v.z * rstd * g.z, v.w * rstd * g.w};
    __builtin_nontemporal_store(o, (nt4*)(row + c)); }
}
DI void row_load_bf(Row4& r, const bf16_t* src, int lane) {
  const uint2 a = *(const uint2*)(src + lane * 4), b = *(const uint2*)(src + 256 + lane * 4), c = *(const uint2*)(src + 512 + lane * 4), d = *(const uint2*)(src + 768 + lane * 4);
  r.a = make_float4(lo16(a.x), hi16(a.x), lo16(a.y), hi16(a.y)); r.b = make_float4(lo16(b.x), hi16(b.x), lo16(b.y), hi16(b.y));
  r.c = make_float4(lo16(c.x), hi16(c.x), lo16(c.y), hi16(c.y)); r.d = make_float4(lo16(d.x), hi16(d.x), lo16(d.y), hi16(d.y));
}
DI void phase8(const Params& P) {
  const bf16_t* PRE = (const bf16_t*)(P.ws + OFF_X1);
  const int lane = threadIdx.x & 63, gw = blockIdx.x * 8 + (threadIdx.x >> 6), nw = gridDim.x * 8;
  for (int m = gw; m < T_LAT; m += 4 * nw) {
    const int m1 = m + nw, m2 = m + 2 * nw, m3 = m + 3 * nw;
    Row4 r0, r1, r2, r3;
    row_load_bf(r0, PRE + (size_t)m * 1024, lane);
    if (m1 < T_LAT) row_load_bf(r1, PRE + (size_t)m1 * 1024, lane);
    if (m2 < T_LAT) row_load_bf(r2, PRE + (size_t)m2 * 1024, lane);
    if (m3 < T_LAT) row_load_bf(r3, PRE + (size_t)m3 * 1024, lane);
    p8_store(P, P.out + (size_t)m * 1024, r0, lane);
    if (m1 < T_LAT) p8_store(P, P.out + (size_t)m1 * 1024, r1, lane);
    if (m2 < T_LAT) p8_store(P, P.out + (size_t)m2 * 1024, r2, lane);
    if (m3 < T_LAT) p8_store(P, P.out + (size_t)m3 * 1024, r3, lane);
  }
}

static_assert(LDS_BYTES >= 2 * ABUF + 16 && LDS_BYTES >= 2 * (BM + BN) * LDT * 2 && LDS_BYTES >= 4096 * 4 + 24 * 64 * 4, "lds");

#define XB_TMO      128
#define XB_XCNT(j)  (256  + 64 * (j))
#define XB_XSUB(j)  (1280 + 64 * (j))
#define XB_XGEN(j)  (2304 + 64 * (j))
#define XB_TOP      3328
#define XB_TOPGEN   3392
#define XCD_BAR_WORDS 3456
#define XB_SPIN_CAP (1u << 20)
DI unsigned xb_ld(unsigned* p) { return __hip_atomic_load(p, __ATOMIC_RELAXED, __HIP_MEMORY_SCOPE_AGENT); }
DI unsigned xb_add(unsigned* p, unsigned v) { return __hip_atomic_fetch_add(p, v, __ATOMIC_RELAXED, __HIP_MEMORY_SCOPE_AGENT); }
DI unsigned xb_xcc_id() { return (unsigned)__builtin_amdgcn_s_getreg((3 << 11) | 20) & 0xFu; }
#define XB_SPIN(cond, bar) do { unsigned _sp = 0; while (cond) { __builtin_amdgcn_s_sleep(1); \
    if ((++_sp & 255u) == 0u) { if (xb_ld(&(bar)[XB_TMO])) break; if (_sp > XB_SPIN_CAP) { atomicAdd(&(bar)[XB_TMO], 1u); break; } } } } while (0)
struct XcdBarrier { unsigned* bar; unsigned x; volatile unsigned* st; };
DI void xcd_barrier_complete(unsigned* bar, unsigned x, unsigned& nloc, unsigned& nx) {
  const unsigned G = gridDim.x;
  unsigned sum, cnt, mine, sp = 0u;
  for (;;) {
    sum = 0u; cnt = 0u; mine = 0u;
#pragma unroll
    for (unsigned j = 0; j < 16; ++j) { const unsigned c = xb_ld(&bar[XB_XCNT(j)]); sum += c; cnt += (c > 0u) ? 1u : 0u; mine = (j == x) ? c : mine; }
    if (sum == G) break;
    __builtin_amdgcn_s_sleep(1);
    if ((++sp & 255u) == 0u) { if (xb_ld(&bar[XB_TMO])) break; if (sp > XB_SPIN_CAP) { atomicAdd(&bar[XB_TMO], 1u); break; } }
  }
  nloc = mine > 0u ? mine : 1u; nx = cnt > 0u ? cnt : 1u;
}
DI void xcd_barrier(const XcdBarrier& b) {
  asm volatile("s_waitcnt vmcnt(0)" ::: "memory");
  __syncthreads();
  if (threadIdx.x == 0) {
    unsigned* bar = b.bar;
    __builtin_amdgcn_s_waitcnt(0);
    unsigned nloc = b.st[0], nx = b.st[1];
    if (nloc == 0u) { xcd_barrier_complete(bar, b.x, nloc, nx); b.st[0] = nloc; b.st[1] = nx; }
    const unsigned old = xb_add(&bar[XB_XSUB(b.x)], 1u);
    const unsigned gen = old / nloc;
    if (old + 1u == (gen + 1u) * nloc) {
      __builtin_amdgcn_fence(__ATOMIC_RELEASE, "agent");
      asm volatile("s_waitcnt vmcnt(0)" ::: "memory");
      const unsigned og = xb_add(&bar[XB_TOP], 1u);
      const unsigned tg = og / nx;
      if (og + 1u == (tg + 1u) * nx) xb_add(&bar[XB_TOPGEN], 1u);
      else XB_SPIN(xb_ld(&bar[XB_TOPGEN]) == tg, bar);
      __builtin_amdgcn_fence(__ATOMIC_ACQUIRE, "agent");
      xb_add(&bar[XB_XGEN(b.x)], 1u);
      asm volatile("s_waitcnt vmcnt(0)" ::: "memory");
    } else {
      XB_SPIN(xb_ld(&bar[XB_XGEN(b.x)]) == gen, bar);
      __builtin_amdgcn_fence(__ATOMIC_ACQUIRE, "agent");
      asm volatile("s_waitcnt vmcnt(0)" ::: "memory");
    }
  }
  __syncthreads();
}

__global__ void __launch_bounds__(NTHR) mega(Params P) {
  __shared__ __attribute__((aligned(16))) unsigned char lds[LDS_BYTES];
  const int lo = P.ph_lo, hi = P.ph_hi;
  __shared__ unsigned bar_st[4];
  if (threadIdx.x < 4) bar_st[threadIdx.x] = 0u;
  __syncthreads();
  XcdBarrier xbar; xbar.bar = (unsigned*)(P.ws + OFF_BAR); xbar.x = xb_xcc_id(); xbar.st = bar_st;
  if (hi - lo > 1 && threadIdx.x == 0) (void)xb_add(&xbar.bar[XB_XCNT(xbar.x)], 1u);
  if (lo < 0) cg::this_grid().sync();
#define GSYNC() xcd_barrier(xbar)
#define PH(k, call) if (lo <= (k) && (k) < hi) { call; if ((k) + 1 < hi) GSYNC(); }
  PH(0, phase0(P, lds))
  PH(1, phase1(P))
#if PROBE == 9
  phase1(P); cg::this_grid().sync();
#elif PROBE == 10
  for (int i = 0; i < 8; ++i) GSYNC();
#endif
  PH(2, phase2(P, lds))
#if PROBE == 3
  phase2(P, lds); GSYNC();
#endif
  PH(3, phase3(P))
#if PROBE == 4
  phase3(P); GSYNC();
#endif
  PH(4, phase4(P, lds))
#if PROBE == 5
  phase4(P, lds); GSYNC();
#endif
  PH(5, phase5(P, lds))
#if PROBE == 6
  phase5(P, lds, 1); cg::this_grid().sync();
#elif PROBE == 7
  phase0(P, lds); cg::this_grid().sync();
#elif PROBE == 1
  cg::this_grid().sync(); if ((int)blockIdx.x < NSCAN) scan_task(P, blockIdx.x, lds); cg::this_grid().sync();
#elif PROBE == 2
  cg::this_grid().sync(); for (int it = blockIdx.x; it < 256; it += gridDim.x) attn_item(P, it, lds); GSYNC();
#endif
  PH(6, phase6(P))
  PH(7, phase7(P, lds))
#if PROBE == 8
  phase7(P, lds); GSYNC();
#endif
  PH(8, phase8(P))
#undef PH
}

extern "C" void kernel_launch(void* const* d_in, const int* in_sizes, int n_in, void* d_out, int out_size, void* d_ws, size_t ws_size, hipStream_t stream) {
  static int grid_blocks = 0;
  if (!grid_blocks) {
    int dev = 0, cus = 0, per_cu = 0;
    hipGetDevice(&dev);
    hipDeviceGetAttribute(&cus, hipDeviceAttributeMultiprocessorCount, dev);
    hipOccupancyMaxActiveBlocksPerMultiprocessor(&per_cu, mega, NTHR, 0);
    if (per_cu < 1) per_cu = 1;
    grid_blocks = cus * per_cu;
    if (ws_size < WS_END) fprintf(stderr, "workspace too small: %zu < %zu\n", ws_size, (size_t)WS_END);
  }
  Params p{};
  const float** pp = (const float**)&p;
  for (int i = 0; i < 24; ++i) pp[i] = (const float*)d_in[i];
  p.out = (float*)d_out; p.ws = (unsigned char*)d_ws;
  hipMemsetAsync((unsigned char*)d_ws + OFF_CTR, 0, (OFF_BAR - OFF_CTR) + XCD_BAR_WORDS * 4, stream);
#if ONE_LAUNCH
  p.ph_lo = 0; p.ph_hi = NPHASE;
  void* args[] = {&p};
  hipError_t e = hipLaunchCooperativeKernel((void*)mega, dim3(grid_blocks), dim3(NTHR), args, 0, stream);
  if (e != hipSuccess) fprintf(stderr, "cooperative launch failed: %s (grid %d)\n", hipGetErrorString(e), grid_blocks);
#else
  for (int ph = 0; ph < NPHASE; ++ph) { p.ph_lo = ph; p.ph_hi = ph + 1; hipLaunchKernelGGL(mega, dim3(grid_blocks), dim3(NTHR), 0, stream, p); }
#endif
}
```
